# Optimizing an MI355X kernel written in HIP

```python
import jax
import jax.numpy as jnp
from jax import lax
import numpy as np

D_MODEL = 1024
BATCH = 4
SEQ = 4096
DEPTH = 2

HEAD_DIM = 64
MIX_WIDTH = D_MODEL // 4
N_BRANCH = 4
NORM_EPS = 1e-6
MASK_VALUE = -1e9
EXP_CLIP = 60.0

HG_HEADS = MIX_WIDTH // HEAD_DIM
GLA_HEADS = 4
GLA_DV = MIX_WIDTH // GLA_HEADS
GLA_DK = GLA_DV // 2
GLA_RANK = 16
GLA_TAU = 16.0
CHUNK = 64
RW_HEADS = MIX_WIDTH // HEAD_DIM
RW_DECAY_LORA = 32
RW_AAA_LORA = 32
RW_MV_LORA = 32
RW_GATE_LORA = 64
RW_GN_EPS = 64e-5
DIL_PAIRS = ((128, 1), (512, 4), (2048, 16))
N_DIL = 3
AT_HEADS = MIX_WIDTH // HEAD_DIM
AT_WIDTH = N_DIL * AT_HEADS * HEAD_DIM
Q_BLOCK = 128
ROPE_THETA = 10000.0
D_FF = 11 * D_MODEL // 4
CONV_W = 3

HG_WIDTH = 4 * MIX_WIDTH
GLA_WIDTH = 2 * GLA_HEADS * GLA_DK + 2 * MIX_WIDTH + GLA_RANK
RW_WIDTH = 3 * MIX_WIDTH + RW_DECAY_LORA + RW_AAA_LORA + RW_GATE_LORA
GATE_WIDTH = N_BRANCH * D_MODEL
N_IN = HG_WIDTH + GLA_WIDTH + RW_WIDTH + 3 * AT_WIDTH + GATE_WIDTH

kernel_name = "hybrid_hgrn2_gla_rwkv7_dilated_gated_merge"

F32 = jnp.float32


def _split(z, widths):
    out, off = [], 0
    for w in widths:
        out.append(z[..., off:off + w])
        off += w
    return out


def rmsnorm(x, w):
    xf = x.astype(F32)
    y = xf * lax.rsqrt(jnp.mean(xf * xf, axis=-1, keepdims=True) + NORM_EPS)
    return (y * w).astype(x.dtype)


def head_rmsnorm(o, n_heads, w):
    B, S, W = o.shape
    of = o.astype(F32).reshape(B, S, n_heads, W // n_heads)
    of = of * lax.rsqrt(jnp.mean(of * of, axis=-1, keepdims=True) + NORM_EPS)
    return (of.reshape(B, S, W) * w).astype(o.dtype)


def to_heads(t, n_heads):
    B, S, W = t.shape
    return t.reshape(B, S, n_heads, W // n_heads).transpose(0, 2, 1, 3)


def from_heads(t):
    B, H, S, Dh = t.shape
    return t.transpose(0, 2, 1, 3).reshape(B, S, H * Dh)


def chunk_gated_linear_attn(q, k, v, log_g):
    B, H, S, Dk = q.shape
    Dv = v.shape[-1]
    nc = S // CHUNK

    def to_chunks(t):
        return jnp.moveaxis(t.astype(F32).reshape(B, H, nc, CHUNK, t.shape[-1]), 2, 0)

    xs = (to_chunks(q), to_chunks(k), to_chunks(v), to_chunks(log_g))
    causal = jnp.tril(jnp.ones((CHUNK, CHUNK), dtype=bool))[:, :, None]

    def step(state, inp):
        qb, kb, vb, gb = inp
        b = jnp.cumsum(gb, axis=2)
        diff = b[:, :, :, None, :] - b[:, :, None, :, :]
        decay = jnp.where(causal, jnp.exp(jnp.where(causal, diff, 0.0)), 0.0)
        scores = jnp.einsum('bhtd,bhsd,bhtsd->bhts', qb, kb, decay)
        o = jnp.einsum('bhts,bhsv->bhtv', scores, vb) + jnp.einsum('bhtk,bhkv->bhtv', qb * jnp.exp(b), state)
        b_last = b[:, :, -1:, :]
        k_dec = kb * jnp.exp(b_last - b)
        state = jnp.exp(b_last[:, :, 0, :, None]) * state + jnp.einsum('bhsk,bhsv->bhkv', k_dec, vb)
        return state, o

    s0 = jnp.zeros((B, H, Dk, Dv), F32)
    _, o = lax.scan(step, s0, xs)
    return jnp.moveaxis(o, 0, 2).reshape(B, H, S, Dv).astype(v.dtype)


def hgrn2_mixer(z, lb, norm_w):
    q_raw, f_raw, i_raw, g_raw = _split(z, (MIX_WIDTH,) * 4)
    fz = f_raw.astype(F32)
    log_f = jax.nn.log_sigmoid(fz) + jnp.log1p(lb * jnp.exp(jnp.minimum(-fz, EXP_CLIP)))
    k = (1.0 - lb) * jax.nn.sigmoid(-fz)
    q = jax.nn.silu(q_raw)
    o = chunk_gated_linear_attn(to_heads(q, HG_HEADS), to_heads(k, HG_HEADS),
                                to_heads(i_raw, HG_HEADS), to_heads(log_f, HG_HEADS))
    return head_rmsnorm(from_heads(o), HG_HEADS, norm_w) * jax.nn.sigmoid(g_raw)


def gla_mixer(z, a_w2, a_b, norm_w):
    q, k, v, g, a_low = _split(z, (GLA_HEADS * GLA_DK, GLA_HEADS * GLA_DK, MIX_WIDTH, MIX_WIDTH, GLA_RANK))
    log_alpha = jax.nn.log_sigmoid((a_low @ a_w2 + a_b).astype(F32)) / GLA_TAU
    o = chunk_gated_linear_attn(to_heads(q, GLA_HEADS) * (GLA_DK ** -0.5), to_heads(k, GLA_HEADS),
                                to_heads(v, GLA_HEADS), to_heads(log_alpha, GLA_HEADS))
    return head_rmsnorm(from_heads(o), GLA_HEADS, norm_w) * jax.nn.silu(g)


def rwkv7_scan(r, w, k, v, kk, a):
    B, S, H, Dh = r.shape

    def step(state, inp):
        r_t, w_t, k_t, v_t, kk_t, a_t = inp
        sa = jnp.einsum('bhvk,bhk->bhv', state, -kk_t)
        state = (state * w_t[:, :, None, :] + sa[..., None] * (kk_t * a_t)[:, :, None, :]
                 + v_t[..., None] * k_t[:, :, None, :])
        return state, jnp.einsum('bhvk,bhk->bhv', state, r_t)

    xs = tuple(jnp.moveaxis(t, 1, 0) for t in (r, w, k, v, kk, a))
    s0 = jnp.zeros((B, H, Dh, Dh), F32)
    _, ys = lax.scan(step, s0, xs)
    return jnp.moveaxis(ys, 0, 1)


def rwkv7_mixer(z, mu, w0, w2, a0, a2, g2, k_k, k_a, r_k, ln_w, ln_b, v_first, v0, v1, v2):
    B, S, _ = z.shape
    z_prev = jnp.pad(z, ((0, 0), (1, 0), (0, 0)))[:, :-1]
    zs = z + mu * (z_prev - z)
    r, wl, k, v, al, gl = _split(zs, (MIX_WIDTH, RW_DECAY_LORA, MIX_WIDTH, MIX_WIDTH, RW_AAA_LORA, RW_GATE_LORA))
    w = -jax.nn.softplus(-(w0 + jnp.tanh(wl) @ w2)) - 0.5
    decay = jnp.exp(-jnp.exp(w.astype(F32)))
    a = jax.nn.sigmoid(a0 + al @ a2)
    g = jax.nn.sigmoid(gl) @ g2
    if v_first is not None:
        v = v + (v_first - v) * jax.nn.sigmoid(v0 + (v @ v1) @ v2)

    def hs(t):
        return t.astype(F32).reshape(B, S, RW_HEADS, HEAD_DIM)

    kk = hs(k * k_k)
    kk = kk / jnp.maximum(jnp.sqrt(jnp.sum(kk * kk, axis=-1, keepdims=True)), 1e-12)
    k_mod = hs(k * (1.0 + (a - 1.0) * k_a))
    rh, vh = hs(r), hs(v)
    y = rwkv7_scan(rh, hs(decay), k_mod, vh, kk, hs(a))
    mean = jnp.mean(y, axis=-1, keepdims=True)
    var = jnp.mean(jnp.square(y - mean), axis=-1, keepdims=True)
    yn = ((y - mean) * lax.rsqrt(var + RW_GN_EPS)).reshape(B, S, MIX_WIDTH) * ln_w + ln_b
    bonus = (jnp.sum(rh * k_mod * r_k.reshape(RW_HEADS, HEAD_DIM), axis=-1, keepdims=True) * vh).reshape(B, S, MIX_WIDTH)
    return ((yn + bonus) * g).astype(z.dtype), v


def rope(x, pos):
    half = HEAD_DIM // 2
    inv = ROPE_THETA ** (-jnp.arange(half, dtype=F32) / half)
    ang = pos.astype(F32)[:, None] * inv[None, :]
    cos, sin = jnp.cos(ang), jnp.sin(ang)
    xf = x.astype(F32)
    x1, x2 = xf[..., :half], xf[..., half:]
    return jnp.concatenate([x1 * cos - x2 * sin, x1 * sin + x2 * cos], axis=-1).astype(x.dtype)


def dilated_window_attention(q, k, v):
    B, G, H, S, Dh = q.shape
    nb = S // Q_BLOCK
    scale = Dh ** -0.5

    def block(start):
        t = start + jnp.arange(Q_BLOCK)
        outs, lses = [], []
        for g, (window, dil) in enumerate(DIL_PAIRS):
            n_keys = window // dil + 1
            idx = t[:, None] - dil * jnp.arange(n_keys)[None, :]
            valid = idx >= 0
            idx = jnp.maximum(idx, 0)
            qb = lax.dynamic_slice_in_dim(q[:, g], start, Q_BLOCK, axis=2)
            kg = jnp.take(k[:, g], idx, axis=2)
            vg = jnp.take(v[:, g], idx, axis=2)
            s = jnp.einsum('bhqd,bhqnd->bhqn', qb, kg).astype(F32) * scale
            s = jnp.where(valid, s, MASK_VALUE)
            lse = jax.nn.logsumexp(s, axis=-1)
            p = jnp.exp(s - lse[..., None])
            outs.append(jnp.einsum('bhqn,bhqnd->bhqd', p, vg.astype(F32)))
            lses.append(lse)
        wts = jax.nn.softmax(jnp.stack(lses, axis=0), axis=0)
        return jnp.sum(wts[..., None] * jnp.stack(outs, axis=0), axis=0)

    ob = lax.map(block, jnp.arange(nb) * Q_BLOCK)
    return jnp.moveaxis(ob, 0, 2).reshape(B, H, S, Dh).astype(q.dtype)


def dilated_mixer(z, pos):
    B, S, _ = z.shape
    q, k, v = _split(z, (AT_WIDTH,) * 3)

    def gh(t):
        return t.reshape(B, S, N_DIL, AT_HEADS, HEAD_DIM).transpose(0, 2, 3, 1, 4)

    o = dilated_window_attention(rope(gh(q), pos), rope(gh(k), pos), gh(v))
    return from_heads(o)


def causal_dwconv(a, w, b):
    S = a.shape[1]
    ap = jnp.pad(a, ((0, 0), (CONV_W - 1, 0), (0, 0)))
    out = b + w[0] * a
    for j in range(1, CONV_W):
        out = out + w[j] * ap[:, CONV_W - 1 - j:CONV_W - 1 - j + S]
    return out


def setup_inputs(seed: int = 0) -> dict:
    key = jax.random.key(seed)
    ks = jax.random.split(key, 32)
    n = lambda i, shape, s: jax.random.normal(ks[i], shape, F32) * s
    one = lambda i, shape: 1.0 + 0.02 * jax.random.normal(ks[i], shape, F32)
    L, W = DEPTH, MIX_WIDTH
    return {
        "x": n(0, (BATCH, SEQ, D_MODEL), 1.0),
        "norm_mix_w": one(1, (L, D_MODEL)),
        "norm_ffn_w": one(2, (L, D_MODEL)),
        "norm_final_w": one(3, (D_MODEL,)),
        "w_in": n(4, (L, D_MODEL, N_IN), D_MODEL ** -0.5),
        "hg_lb_table": n(5, (L, W), 0.5),
        "hg_norm_w": one(6, (L, W)),
        "gla_a_w2": n(7, (L, GLA_RANK, GLA_HEADS * GLA_DK), GLA_RANK ** -0.5),
        "gla_a_b": n(8, (L, GLA_HEADS * GLA_DK), 0.1),
        "gla_norm_w": one(9, (L, W)),
        "rw_mu": jax.random.uniform(ks[10], (L, RW_WIDTH), F32),
        "rw_w0": jax.random.uniform(ks[11], (L, W), F32, minval=-5.0, maxval=0.0),
        "rw_w2": n(12, (L, RW_DECAY_LORA, W), 0.5 * RW_DECAY_LORA ** -0.5),
        "rw_a0": n(13, (L, W), 0.1),
        "rw_a2": n(14, (L, RW_AAA_LORA, W), RW_AAA_LORA ** -0.5),
        "rw_g2": n(15, (L, RW_GATE_LORA, W), RW_GATE_LORA ** -0.5),
        "rw_k_k": 0.85 + n(16, (L, W), 0.1),
        "rw_k_a": 1.0 + n(17, (L, W), 0.1),
        "rw_r_k": n(18, (L, W), 0.1),
        "rw_ln_w": one(19, (L, W)),
        "rw_ln_b": n(20, (L, W), 0.02),
        "rw_v0": n(21, (L - 1, W), 0.1),
        "rw_v1": n(22, (L - 1, W, RW_MV_LORA), W ** -0.5),
        "rw_v2": n(23, (L - 1, RW_MV_LORA, W), RW_MV_LORA ** -0.5),
        "w_branch": n(24, (L, N_BRANCH, W, D_MODEL), W ** -0.5),
        "w_out": n(25, (L, D_MODEL, D_MODEL), D_MODEL ** -0.5),
        "ffn_w_up": n(26, (L, D_MODEL, 2 * D_FF), D_MODEL ** -0.5),
        "ffn_conv_w": n(27, (L, CONV_W, D_FF), CONV_W ** -0.5),
        "ffn_conv_b": n(28, (L, D_FF), 0.02),
        "ffn_w_down": n(29, (L, D_FF, D_MODEL), D_FF ** -0.5),
    }


def reference(x, norm_mix_w, norm_ffn_w, norm_final_w, w_in, hg_lb_table, hg_norm_w, gla_a_w2, gla_a_b,
              gla_norm_w, rw_mu, rw_w0, rw_w2, rw_a0, rw_a2, rw_g2, rw_k_k, rw_k_a, rw_r_k, rw_ln_w, rw_ln_b,
              rw_v0, rw_v1, rw_v2, w_branch, w_out, ffn_w_up, ffn_conv_w, ffn_conv_b, ffn_w_down):
    B, S, _ = x.shape
    pos = jnp.arange(S, dtype=jnp.int32)
    p_lb = jax.nn.softmax(hg_lb_table.astype(F32), axis=0)
    lower_bounds = jnp.cumsum(p_lb, axis=0) - p_lb[0:1]
    v_first = None
    for layer in range(DEPTH):
        h = rmsnorm(x, norm_mix_w[layer])
        z = h @ w_in[layer]
        z_hg, z_gla, z_rw, z_at, z_gate = _split(z, (HG_WIDTH, GLA_WIDTH, RW_WIDTH, 3 * AT_WIDTH, GATE_WIDTH))
        o_a = hgrn2_mixer(z_hg, lower_bounds[layer], hg_norm_w[layer])
        o_b = gla_mixer(z_gla, gla_a_w2[layer], gla_a_b[layer], gla_norm_w[layer])
        if layer == 0:
            o_c, v_first = rwkv7_mixer(z_rw, rw_mu[layer], rw_w0[layer], rw_w2[layer], rw_a0[layer], rw_a2[layer],
                                       rw_g2[layer], rw_k_k[layer], rw_k_a[layer], rw_r_k[layer], rw_ln_w[layer],
                                       rw_ln_b[layer], None, None, None, None)
        else:
            o_c, _ = rwkv7_mixer(z_rw, rw_mu[layer], rw_w0[layer], rw_w2[layer], rw_a0[layer], rw_a2[layer],
                                 rw_g2[layer], rw_k_k[layer], rw_k_a[layer], rw_r_k[layer], rw_ln_w[layer],
                                 rw_ln_b[layer], v_first, rw_v0[layer - 1], rw_v1[layer - 1], rw_v2[layer - 1])
        o_d = dilated_mixer(z_at, pos)
        branches = jnp.stack([o_a, o_b, o_c, o_d], axis=2)
        proj = jnp.einsum('bsnw,nwd->bsnd', branches, w_branch[layer])
        gates = jax.nn.sigmoid(z_gate.reshape(B, S, N_BRANCH, D_MODEL))
        x = x + jnp.sum(gates * proj, axis=2) @ w_out[layer]
        h2 = rmsnorm(x, norm_ffn_w[layer])
        up, gate_ff = _split(h2 @ ffn_w_up[layer], (D_FF, D_FF))
        up = causal_dwconv(up, ffn_conv_w[layer], ffn_conv_b[layer])
        x = x + (jax.nn.silu(up) * gate_ff) @ ffn_w_down[layer]
    return rmsnorm(x, norm_final_w)
```

```cpp
#include <hip/hip_runtime.h>
#include <hip/hip_cooperative_groups.h>
#include <cstdio>
#include <cstdint>
namespace cg = cooperative_groups;
#define DI __device__ __forceinline__
DI int lane_id_() { int l; asm volatile("v_mbcnt_lo_u32_b32 %0, -1, 0\n\tv_mbcnt_hi_u32_b32 %0, -1, %0" : "=v"(l)); return l; }
namespace pg8 {
#define PG8_LAS __attribute__((address_space(3)))
typedef unsigned short bf16_t;
typedef short bf16x8 __attribute__((ext_vector_type(8)));
typedef float f32x4 __attribute__((ext_vector_type(4)));
typedef unsigned u32x4 __attribute__((ext_vector_type(4)));
constexpr int BM = 256, BK = 64, HALF = 128, HTB = HALF * BK * 2  , STAGE_BYTES = 8 * HTB, NXCD = 8, WGM = 8;

__host__ __device__ __forceinline__ int lds_byte(int r, int c) { const int st = (r >> 4) * 2 + (c >> 5), rr = r & 15, cc = c & 31, ob = rr * 64 + cc * 2; return st * 1024 + (ob ^ (((ob >> 9) & 1) << 5)); }
__host__ __device__ __forceinline__ void stage_rc(int b, int& R, int& C) { const int st = b / 1024, sb = b % 1024, swz = sb ^ (((sb >> 9) & 1) << 5); R = (st >> 1) * 16 + swz / 64; C = (st & 1) * 32 + (swz % 64) / 2; }
__host__ __device__ __forceinline__ int perm32(int rho) { const int n = rho >> 4, i = rho & 15; return 8 * (i >> 2) + 4 * n + (i & 3); }

struct Unit { int pm, pn; };
struct Gemm { const bf16_t* A; const bf16_t* Bt; int M, N, K; };

struct StaticOrder {
    int nM, nN, nwg, G, c;
    __host__ __device__ void init(int M, int N, int G_, int c_) { nM = M / BM; nN = N / BM; nwg = nM * nN; G = G_; c = c_; }
    __host__ __device__ bool next(int i, Unit& u) const {
        const long L = (long)i * G + c; if (L >= nwg) return false;
        int wgid = (int)L; { const int q = nwg / NXCD, r = nwg % NXCD, xcd = wgid % NXCD, off = wgid / NXCD; wgid = (xcd < r ? xcd * (q + 1) : r * (q + 1) + (xcd - r) * q) + off; }
        const int nig = WGM * nN, gid = wgid / nig, fm = gid * WGM, gsz = (nM - fm) < WGM ? (nM - fm) : WGM;
        u.pm = fm + ((wgid % nig) % gsz); u.pn = (wgid % nig) / gsz; return true;
    }
    __device__ __forceinline__ void a_ready(const Unit&) const {}
    __device__ __forceinline__ void done(const Unit&) const {}
};
__device__ __forceinline__ unsigned cvt_pk_bf16(float lo, float hi) { unsigned r; asm volatile("v_cvt_pk_bf16_f32 %0, %1, %2" : "=v"(r) : "v"(lo), "v"(hi)); return r; }
typedef float f32x2 __attribute__((ext_vector_type(2)));
template <class Epi, class Sched, bool ALIGN_EPI = false, bool SP2 = false>
__device__ __forceinline__ void gemm_phase(PG8_LAS unsigned char* lds, const Gemm g, const Sched& S, const Epi& E, int wave0) {
    int tid_ = wave0 * 64 + lane_id_();
    const int tid = tid_, wid = __builtin_amdgcn_readfirstlane(tid >> 6), lane = tid & 63, wr = wid >> 2, wc = wid & 3, fr = lane & 15, fq = lane >> 4;
    const int K = g.K, nt = K / BK;
    unsigned voffA[2], voffB[2];
#pragma unroll
    for (int i = 0; i < 2; ++i) { int R, C; stage_rc(tid * 16 + i * 8192, R, C); const int Rb = Epi::PERM ? ((R & ~31) + perm32(R & 31)) : R;
        voffA[i] = (unsigned)(R * K + C) * 2u; voffB[i] = (unsigned)(Rb * K + C) * 2u; }
    const size_t kstep = (size_t)(BK * 2);
    const size_t hstep = (size_t)HALF * K * 2;
    const size_t tstep = 2 * hstep;
    const unsigned ldsw = (unsigned)wid * 1024u;
    const int aoff = lds_byte(wr * 64 + fr, fq * 8), boff = lds_byte(wc * 32 + fr, fq * 8);
#define PG8_SA(b, h) (((b) * 2 + (h)) * HTB)
#define PG8_SB(b, h) ((4 + (b) * 2 + (h)) * HTB)
#define PG8_STAGE(bufoff, gbase, voff) do { _Pragma("unroll") for (int _i = 0; _i < 2; ++_i) \
        __builtin_amdgcn_global_load_lds((const unsigned*)((const char*)(gbase) + (voff)[_i]), (PG8_LAS unsigned*)(lds + (bufoff) + ldsw + _i * 8192), 16, 0, 0); } while (0)
#define PG8_LDA(dst, b, h) do { _Pragma("unroll") for (int m = 0; m < 4; ++m) _Pragma("unroll") for (int k = 0; k < 2; ++k) dst[m][k] = *(const PG8_LAS bf16x8*)(lds + PG8_SA(b, h) + aoff + m * 2048 + k * 1024); } while (0)
#define PG8_LDB(dst, b, h) do { _Pragma("unroll") for (int n = 0; n < 2; ++n) _Pragma("unroll") for (int k = 0; k < 2; ++k) dst[n][k] = *(const PG8_LAS bf16x8*)(lds + PG8_SB(b, h) + boff + n * 2048 + k * 1024); } while (0)
#define PG8_MMA(ai, bj, At, Bt) do { __builtin_amdgcn_s_setprio(1); _Pragma("unroll") for (int m = 0; m < 4; ++m) _Pragma("unroll") for (int n = 0; n < 2; ++n) _Pragma("unroll") for (int k = 0; k < 2; ++k) \
        acc[ai][bj][m][n] = __builtin_amdgcn_mfma_f32_16x16x32_bf16(Bt[n][k], At[m][k], acc[ai][bj][m][n], 0, 0, 0); __builtin_amdgcn_s_setprio(0); } while (0)
#define PG8_WAIT_V(n) asm volatile("s_waitcnt vmcnt(" #n ")" ::: "memory")
#define PG8_WAIT_L(n) asm volatile("s_waitcnt lgkmcnt(" #n ")" ::: "memory")
#define PG8_BAR __builtin_amdgcn_s_barrier()
#define PG8_SCHED __builtin_amdgcn_sched_barrier(0)
    Unit cur, nxt; int ui = 0;
    if (!S.next(0, cur)) return;
    f32x4 acc[2][2][4][2];
#pragma unroll
    for (int a = 0; a < 2; ++a)
#pragma unroll
        for (int b = 0; b < 2; ++b)
#pragma unroll
            for (int m = 0; m < 4; ++m)
#pragma unroll
                for (int n = 0; n < 2; ++n) acc[a][b][m][n] = (f32x4){0.f, 0.f, 0.f, 0.f};
    bf16x8 At[4][2], B0[2][2], B1[2][2];
    const char* cA = (const char*)g.A + (size_t)cur.pm * tstep; const char* cB = (const char*)g.Bt + (size_t)cur.pn * tstep;
    S.a_ready(cur);
    if constexpr (SP2) {
        PG8_STAGE(PG8_SB(0, 0), cB, voffB); PG8_STAGE(PG8_SB(0, 1), cB + hstep, voffB); PG8_STAGE(PG8_SA(0, 0), cA, voffA); PG8_STAGE(PG8_SA(0, 1), cA + hstep, voffA);
        if (wr == 1) PG8_BAR;
        PG8_WAIT_V(2); PG8_BAR;
        PG8_STAGE(PG8_SB(1, 0), cB + kstep, voffB); PG8_STAGE(PG8_SA(1, 0), cA + kstep, voffA); PG8_STAGE(PG8_SB(1, 1), cB + hstep + kstep, voffB);
        PG8_WAIT_V(6); PG8_BAR;
    } else {
        PG8_STAGE(PG8_SB(0, 0), cB, voffB); PG8_STAGE(PG8_SA(0, 0), cA, voffA); PG8_STAGE(PG8_SB(0, 1), cB + hstep, voffB); PG8_STAGE(PG8_SA(0, 1), cA + hstep, voffA);
        if (wr == 1) PG8_BAR;
        PG8_WAIT_V(4); PG8_BAR;
        PG8_STAGE(PG8_SB(1, 0), cB + kstep, voffB); PG8_STAGE(PG8_SA(1, 0), cA + kstep, voffA); PG8_STAGE(PG8_SB(1, 1), cB + hstep + kstep, voffB);
        PG8_WAIT_V(6); PG8_BAR;
    }
    for (;;) {
        const bool has_next = S.next(ui + 1, nxt);
        const char* nA = has_next ? (const char*)g.A + (size_t)nxt.pm * tstep : cA; const char* nB = has_next ? (const char*)g.Bt + (size_t)nxt.pn * tstep : cB;
        for (int t = 0; t < nt; t += 2) {
            const bool last = (t == nt - 2);
            const char* a1 = cA + (size_t)(t + 1) * kstep;
            const char* a2 = last ? nA : cA + (size_t)(t + 2) * kstep; const char* b2 = last ? nB : cB + (size_t)(t + 2) * kstep;
            const char* a3 = a2 + kstep; const char* b3 = b2 + kstep;
            if (last && has_next) S.a_ready(nxt);
            if constexpr (SP2) {
            PG8_LDB(B0, 0, 0); PG8_LDB(B1, 0, 1); PG8_SCHED; PG8_LDA(At, 0, 0); PG8_STAGE(PG8_SA(1, 1), a1 + hstep, voffA);
            PG8_WAIT_V(8); PG8_WAIT_L(0); PG8_BAR; PG8_MMA(0, 0, At, B0); PG8_MMA(0, 1, At, B1); PG8_BAR; PG8_SCHED;
            PG8_LDA(At, 0, 1); PG8_STAGE(PG8_SB(0, 0), b2, voffB); PG8_STAGE(PG8_SB(0, 1), b2 + hstep, voffB); PG8_STAGE(PG8_SA(0, 0), a2, voffA);
            PG8_WAIT_V(8); PG8_WAIT_L(0); PG8_BAR; PG8_MMA(1, 0, At, B0); PG8_MMA(1, 1, At, B1); PG8_BAR; PG8_SCHED;
            PG8_LDB(B0, 1, 0); PG8_LDB(B1, 1, 1); PG8_SCHED; PG8_LDA(At, 1, 0); PG8_STAGE(PG8_SA(0, 1), a2 + hstep, voffA);
            PG8_WAIT_V(8); PG8_WAIT_L(0); PG8_BAR; PG8_MMA(0, 0, At, B0); PG8_MMA(0, 1, At, B1); PG8_BAR; PG8_SCHED;
            PG8_LDA(At, 1, 1); PG8_STAGE(PG8_SB(1, 0), b3, voffB); PG8_STAGE(PG8_SB(1, 1), b3 + hstep, voffB); PG8_STAGE(PG8_SA(1, 0), a3, voffA);
            PG8_WAIT_V(8); PG8_WAIT_L(0); PG8_BAR; PG8_MMA(1, 0, At, B0); PG8_MMA(1, 1, At, B1); PG8_BAR; PG8_SCHED;
            } else {
            PG8_LDB(B0, 0, 0); PG8_SCHED; PG8_LDA(At, 0, 0); PG8_STAGE(PG8_SA(1, 1), a1 + hstep, voffA);
            PG8_WAIT_L(8); PG8_BAR; PG8_WAIT_L(0); PG8_MMA(0, 0, At, B0); PG8_BAR; PG8_SCHED;
            PG8_LDB(B1, 0, 1); PG8_STAGE(PG8_SB(0, 0), b2, voffB);
            PG8_BAR; PG8_WAIT_L(0); PG8_MMA(0, 1, At, B1); PG8_BAR;
            PG8_LDA(At, 0, 1); PG8_STAGE(PG8_SA(0, 0), a2, voffA);
            PG8_BAR; PG8_WAIT_L(0); PG8_MMA(1, 0, At, B0); PG8_BAR; PG8_SCHED;
            PG8_STAGE(PG8_SB(0, 1), b2 + hstep, voffB);
            PG8_WAIT_V(6); PG8_BAR; PG8_MMA(1, 1, At, B1); PG8_BAR;
            PG8_LDB(B0, 1, 0); PG8_SCHED; PG8_LDA(At, 1, 0); PG8_STAGE(PG8_SA(0, 1), a2 + hstep, voffA);
            PG8_WAIT_L(8); PG8_BAR; PG8_WAIT_L(0); PG8_MMA(0, 0, At, B0); PG8_BAR; PG8_SCHED;
            PG8_LDB(B1, 1, 1); PG8_STAGE(PG8_SB(1, 0), b3, voffB);
            PG8_BAR; PG8_WAIT_L(0); PG8_MMA(0, 1, At, B1); PG8_BAR;
            PG8_LDA(At, 1, 1); PG8_STAGE(PG8_SA(1, 0), a3, voffA);
            PG8_BAR; PG8_WAIT_L(0); PG8_MMA(1, 0, At, B0); PG8_BAR; PG8_SCHED;
            PG8_STAGE(PG8_SB(1, 1), b3 + hstep, voffB);
            PG8_WAIT_V(6); PG8_BAR; PG8_MMA(1, 1, At, B1); PG8_BAR;
            }
        }
        if constexpr (ALIGN_EPI) { if (wr == 0) PG8_BAR; }
        if constexpr (!Epi::AFTER_DRAIN) { E(acc, cur, wr, wc, fr, fq); S.done(cur); }
        if (!has_next) break;
#pragma unroll
        for (int a = 0; a < 2; ++a)
#pragma unroll
            for (int b = 0; b < 2; ++b)
#pragma unroll
                for (int m = 0; m < 4; ++m)
#pragma unroll
                    for (int n = 0; n < 2; ++n) acc[a][b][m][n] = (f32x4){0.f, 0.f, 0.f, 0.f};
        cur = nxt; cA = nA; cB = nB; ++ui;
        if constexpr (ALIGN_EPI) { if (wr == 1) PG8_BAR; }
    }
    PG8_WAIT_V(0);
    if constexpr (!ALIGN_EPI) { if (wr == 0) PG8_BAR; }
    PG8_BAR;
    if constexpr (Epi::AFTER_DRAIN) { E.fused(acc, cur, wr, wc, fr, fq, lds, wid, lane); S.done(cur); }
#undef PG8_SA
#undef PG8_SB
#undef PG8_STAGE
#undef PG8_LDA
#undef PG8_LDB
#undef PG8_MMA
#undef PG8_WAIT_V
#undef PG8_WAIT_L
#undef PG8_BAR
#undef PG8_SCHED
}
}

typedef unsigned short bf16_t;
typedef float f32x4 __attribute__((ext_vector_type(4)));
typedef short bf16x8 __attribute__((ext_vector_type(8)));
typedef unsigned u32x4 __attribute__((ext_vector_type(4)));
typedef unsigned u32x2 __attribute__((ext_vector_type(2)));

constexpr int T = 16384, SEQ = 4096, DM = 1024, NIN = 9104, DFF = 2816;
constexpr int NZ = 5120;
constexpr int ZAW = 1792;
constexpr float NEPS = 1e-6f;
constexpr size_t MiB = 1u << 20;
constexpr size_t WS_CTL = 0;
constexpr size_t WS_ROPEC = 1 * MiB, WS_ROPES = WS_ROPEC + 512 * 1024;
constexpr size_t WS_LSE = 2 * MiB, WS_BONUS = WS_LSE + 768 * 1024;
constexpr size_t WS_WZ = 3 * MiB, WS_WG = WS_WZ + (size_t)NZ * 1024 * 2, WS_WB = WS_WG + 8 * MiB, WS_WO = WS_WB + 2 * MiB, WS_WUP = WS_WO + 2 * MiB, WS_WDN = WS_WUP + 11 * MiB;
static_assert(WS_WDN + (size_t)1024 * 2816 * 2 <= 42 * MiB, "weight region");
constexpr size_t WS_VRW = 42 * MiB;
constexpr size_t WS_OM = 50 * MiB;
constexpr size_t WS_ZA = 82 * MiB;
constexpr size_t WS_ZT = 146 * MiB;
constexpr size_t WS_RW = 218 * MiB;
constexpr size_t SLOT = 8 * MiB;
constexpr size_t WS_XN = 242 * MiB;
constexpr size_t WS_PROJ = 82 * MiB;
constexpr size_t WS_MERGED = 210 * MiB;
constexpr size_t WS_XN2 = 242 * MiB;
constexpr size_t WS_U = 50 * MiB, WS_G = 138 * MiB;
constexpr size_t WS_ACT = 138 * MiB;
constexpr size_t WS_EDGE = 50 * MiB;
constexpr size_t WS_SSQ = 274 * MiB;
constexpr size_t WS_END = 275 * MiB;

constexpr int LDS_BYTES = 147456, LDS_MISC = 131072;

DI float bf2f(unsigned v) { return __uint_as_float(v << 16); }
DI float bflo(unsigned w) { return __uint_as_float(w << 16); }
DI float bfhi(unsigned w) { return __uint_as_float(w & 0xffff0000u); }
DI unsigned pk2(float lo, float hi) { return pg8::cvt_pk_bf16(lo, hi); }
DI bf16_t f2bf(float f) { return (bf16_t)(pk2(f, 0.f) & 0xffffu); }
DI float sigmoidf_(float x) { return __builtin_amdgcn_rcpf(1.f + __expf(-x)); }
DI float siluf_(float x) { return x * __builtin_amdgcn_rcpf(1.f + __expf(-x)); }
DI void unpack8(u32x4 v, float* f) { f[0] = bflo(v.x); f[1] = bfhi(v.x); f[2] = bflo(v.y); f[3] = bfhi(v.y); f[4] = bflo(v.z); f[5] = bfhi(v.z); f[6] = bflo(v.w); f[7] = bfhi(v.w); }
DI u32x4 pack8(const float* f) { u32x4 v; v.x = pk2(f[0], f[1]); v.y = pk2(f[2], f[3]); v.z = pk2(f[4], f[5]); v.w = pk2(f[6], f[7]); return v; }
template <int CTRL> DI float dpp_mov(float x);
DI float wave_sum(float v);
template <int CTRL> DI float dpp_mov(float x) { return __int_as_float(__builtin_amdgcn_update_dpp(0, __float_as_int(x), CTRL, 0xf, 0xf, true)); }
template <int NL> DI float grp_sum(float x) {
    x += dpp_mov<0xB1>(x); x += dpp_mov<0x4E>(x); x += dpp_mov<0x141>(x); if (NL == 16) x += dpp_mov<0x140>(x); return x;
}
DI float wave_sum(float v) {
    v += dpp_mov<0xB1>(v); v += dpp_mov<0x4E>(v); v += dpp_mov<0x141>(v); v += dpp_mov<0x140>(v);
    const int iv = __float_as_int(v);
    const float a = __int_as_float(__builtin_amdgcn_readlane(iv, 0)), b = __int_as_float(__builtin_amdgcn_readlane(iv, 16));
    const float c = __int_as_float(__builtin_amdgcn_readlane(iv, 32)), d = __int_as_float(__builtin_amdgcn_readlane(iv, 48));
    return (a + b) + (c + d);
}
DI float grp_max16(float x) {
    x = fmaxf(x, dpp_mov<0xB1>(x)); x = fmaxf(x, dpp_mov<0x4E>(x)); x = fmaxf(x, dpp_mov<0x141>(x)); x = fmaxf(x, dpp_mov<0x140>(x)); return x;
}
#define LDS_FENCE() do { asm volatile("s_waitcnt lgkmcnt(0)" ::: "memory"); __builtin_amdgcn_wave_barrier(); asm volatile("" ::: "memory"); } while (0)

struct Params { const float* in[30]; float* out; unsigned char* ws; };

typedef __attribute__((address_space(4))) const Params* KArg;
struct Ctx {
    KArg p; int layer; int tid, lane, wave, G, bid;
    unsigned char* ws; unsigned char* lds;
    DI const float* in(int i) const { return p->in[i]; }
};
typedef f32x4 Acc[2][2][4][2];
struct EpiZ {
    static constexpr bool PERM = true, AFTER_DRAIN = false;
    bf16_t *ZA, *ZR, *ZT; const float *rc, *rs;
    DI void operator()(const Acc& acc, const pg8::Unit& u, int wr, int wc, int fr_, int fq_) const {
        int fr = fr_, fq = fq_; asm volatile("" : "+v"(fr), "+v"(fq));
        const int pn = u.pn; bf16_t* base; int ld, colt; bool rope = false; float qs = 1.f;
        if (pn < 7) { base = ZA; ld = ZAW; colt = pn * 256; }
        else if (pn < 11) { base = ZR; ld = 1024; colt = (pn - 7) * 256; }
        else { base = ZT; ld = 2304; colt = (pn - 11) * 256; rope = pn < 17; qs = pn < 14 ? 0.125f : 1.f; }
        const int row0 = u.pm * 256 + wr * 64 + fr;
#pragma unroll
        for (int ai = 0; ai < 2; ++ai)
#pragma unroll
            for (int m = 0; m < 4; ++m) {
                const int row = row0 + ai * 128 + m * 16;
                bf16_t* rowp = base + (size_t)row * ld + colt;
                if (!rope) {
#pragma unroll
                    for (int bj = 0; bj < 2; ++bj) {
                        const f32x4 v0 = acc[ai][bj][m][0], v1 = acc[ai][bj][m][1]; u32x4 w;
                        w.x = pk2(v0[0], v0[1]); w.y = pk2(v0[2], v0[3]); w.z = pk2(v1[0], v1[1]); w.w = pk2(v1[2], v1[3]);
                        *(u32x4*)(rowp + bj * 128 + wc * 32 + 8 * fq) = w;
                    }
                } else {
                    const int pos = row & (SEQ - 1);
                    const f32x4 c0 = *(const f32x4*)(rc + pos * 32 + 8 * fq), c1 = *(const f32x4*)(rc + pos * 32 + 8 * fq + 4);
                    const f32x4 s0 = *(const f32x4*)(rs + pos * 32 + 8 * fq), s1 = *(const f32x4*)(rs + pos * 32 + 8 * fq + 4);
                    const f32x4 a0 = acc[ai][0][m][0], a1 = acc[ai][0][m][1], b0 = acc[ai][1][m][0], b1 = acc[ai][1][m][1];
                    const f32x4 o10 = (a0 * c0 - b0 * s0) * qs, o11 = (a1 * c1 - b1 * s1) * qs;
                    const f32x4 o20 = (a0 * s0 + b0 * c0) * qs, o21 = (a1 * s1 + b1 * c1) * qs;
                    u32x4 w1, w2;
                    w1.x = pk2(o10[0], o10[1]); w1.y = pk2(o10[2], o10[3]); w1.z = pk2(o11[0], o11[1]); w1.w = pk2(o11[2], o11[3]);
                    w2.x = pk2(o20[0], o20[1]); w2.y = pk2(o20[2], o20[3]); w2.z = pk2(o21[0], o21[1]); w2.w = pk2(o21[2], o21[3]);
                    *(u32x4*)(rowp + wc * 64 + 8 * fq) = w1;
                    *(u32x4*)(rowp + wc * 64 + 32 + 8 * fq) = w2;
                }
            }
    }
};
template <int ACT  > struct EpiSplit {
    static constexpr bool PERM = true, AFTER_DRAIN = false;
    bf16_t* O; int ld; int tiles_per; size_t stride;
    DI void operator()(const Acc& acc, const pg8::Unit& u, int wr, int wc, int fr_, int fq_) const {
        int fr = fr_, fq = fq_; asm volatile("" : "+v"(fr), "+v"(fq));
        const int t = u.pn / tiles_per, colt = (u.pn - t * tiles_per) * 256;
        bf16_t* base = O + (size_t)t * stride;
        const int row0 = u.pm * 256 + wr * 64 + fr;
#pragma unroll
        for (int ai = 0; ai < 2; ++ai)
#pragma unroll
            for (int m = 0; m < 4; ++m) {
                bf16_t* rowp = base + (size_t)(row0 + ai * 128 + m * 16) * ld + colt + wc * 32 + 8 * fq;
#pragma unroll
                for (int bj = 0; bj < 2; ++bj) {
                    f32x4 v0 = acc[ai][bj][m][0], v1 = acc[ai][bj][m][1];
                    if (ACT == 1) {
#pragma unroll
                        for (int j = 0; j < 4; ++j) { v0[j] = sigmoidf_(v0[j]); v1[j] = sigmoidf_(v1[j]); }
                    }
                    u32x4 w; w.x = pk2(v0[0], v0[1]); w.y = pk2(v0[2], v0[3]); w.z = pk2(v1[0], v1[1]); w.w = pk2(v1[2], v1[3]);
                    *(u32x4*)(rowp + bj * 128) = w;
                }
            }
    }
};
struct EpiProj {
    static constexpr bool PERM = true, AFTER_DRAIN = false;
    bf16_t* gates; float* mf;
    DI void operator()(const Acc& acc, const pg8::Unit& u, int wr, int wc, int fr_, int fq_) const {
        int fr = fr_, fq = fq_; asm volatile("" : "+v"(fr), "+v"(fq));
        const int n = u.pm >> 6, pm = u.pm & 63, pn = u.pn & 3;
        const bf16_t* gs = gates + (size_t)n * T * 1024;
        const int row0 = pm * 256 + wr * 64 + fr, col0 = pn * 256 + wc * 32 + 8 * fq;
#pragma unroll
        for (int ai = 0; ai < 2; ++ai)
#pragma unroll
            for (int m = 0; m < 4; ++m)
#pragma unroll
                for (int bj = 0; bj < 2; ++bj) {
                    const size_t off = (size_t)(row0 + ai * 128 + m * 16) * 1024 + col0 + bj * 128;
                    float g[8]; unpack8(*(const u32x4*)(gs + off), g);
                    const f32x4 v0 = acc[ai][bj][m][0], v1 = acc[ai][bj][m][1];
                    f32x4 r0 = (f32x4){g[0] * v0[0], g[1] * v0[1], g[2] * v0[2], g[3] * v0[3]};
                    f32x4 r1 = (f32x4){g[4] * v1[0], g[5] * v1[1], g[6] * v1[2], g[7] * v1[3]};
                    if (n > 0) { r0 += *(const f32x4*)(mf + off); r1 += *(const f32x4*)(mf + off + 4); }
                    if (n < 3) { *(f32x4*)(mf + off) = r0; *(f32x4*)(mf + off + 4) = r1; }
                    else { u32x4 w; w.x = pk2(r0[0], r0[1]); w.y = pk2(r0[2], r0[3]); w.z = pk2(r1[0], r1[1]); w.w = pk2(r1[2], r1[3]); *(u32x4*)(gates + off) = w; }
                }
    }
};
struct EpiGateMerge {
    static constexpr bool PERM = true, AFTER_DRAIN = false;
    const bf16_t* proj; bf16_t* merged;
    DI void operator()(const Acc& acc, const pg8::Unit& u, int wr, int wc, int fr_, int fq_) const {
        int fr = fr_, fq = fq_; asm volatile("" : "+v"(fr), "+v"(fq));
        const int row0 = u.pm * 256 + wr * 64 + fr, d0 = u.pn * 64 + wc * 16 + fq * 4;
#pragma unroll
        for (int ai = 0; ai < 2; ++ai)
#pragma unroll
            for (int m = 0; m < 4; ++m) {
                const size_t off = (size_t)(row0 + ai * 128 + m * 16) * 1024 + d0;
                f32x4 r = (f32x4){0.f, 0.f, 0.f, 0.f};
#pragma unroll
                for (int bj = 0; bj < 2; ++bj)
#pragma unroll
                    for (int nn = 0; nn < 2; ++nn) {
                        const u32x2 pw = *(const u32x2*)(proj + (size_t)(2 * bj + nn) * T * 1024 + off);
                        const f32x4 g = acc[ai][bj][m][nn];
                        r[0] += sigmoidf_(g[0]) * bflo(pw.x); r[1] += sigmoidf_(g[1]) * bfhi(pw.x); r[2] += sigmoidf_(g[2]) * bflo(pw.y); r[3] += sigmoidf_(g[3]) * bfhi(pw.y);
                    }
                u32x2 w; w.x = pk2(r[0], r[1]); w.y = pk2(r[2], r[3]);
                *(u32x2*)(merged + off) = w;
                asm volatile("" ::: "memory");
            }
    }
};
struct ProjOrder {
    int G, c;
    DI bool next(int i, pg8::Unit& u) const { const int j = c + (i >> 2) * G; if (j >= 256) return false; const int n = i & 3; u.pm = n * 64 + (j >> 2); u.pn = n * 4 + (j & 3); return true; }
    DI void a_ready(const pg8::Unit&) const {}
    DI void done(const pg8::Unit&) const {}
};
struct GateOrder {
    int G, c;
    DI bool next(int i, pg8::Unit& u) const { const int j = c + (i >> 2) * G; if (j >= 256) return false; u.pm = j >> 2; u.pn = (j & 3) * 4 + (i & 3); return true; }
    DI void a_ready(const pg8::Unit&) const {}
    DI void done(const pg8::Unit&) const {}
};
template <bool EMIT> struct EpiRes {
    static constexpr bool PERM = false, AFTER_DRAIN = false;
    const float* res; float* out; bf16_t* xb; float* ssq;
    DI void operator()(const Acc& acc, const pg8::Unit& u, int wr, int wc, int fr_, int fq_) const {
        int fr = fr_, fq = fq_; asm volatile("" : "+v"(fr), "+v"(fq));
        const int row0 = u.pm * 256 + wr * 64 + fr, col0 = u.pn * 256 + wc * 32 + 4 * fq;
        const int lane = fq * 16 + fr;
#pragma unroll
        for (int ai = 0; ai < 2; ++ai)
#pragma unroll
            for (int m = 0; m < 4; ++m) {
                const int row = row0 + ai * 128 + m * 16; float sq = 0.f;
#pragma unroll
                for (int bj = 0; bj < 2; ++bj)
#pragma unroll
                    for (int n = 0; n < 2; ++n) {
                        const size_t off = (size_t)row * 1024 + col0 + bj * 128 + n * 16;
                        const f32x4 o = *(const f32x4*)(res + off) + acc[ai][bj][m][n];
                        *(f32x4*)(out + off) = o;
                        if (EMIT) { sq += (o[0] * o[0] + o[1] * o[1]) + (o[2] * o[2] + o[3] * o[3]); u32x2 w; w.x = pk2(o[0], o[1]); w.y = pk2(o[2], o[3]); *(u32x2*)(xb + off) = w; }
                    }
                if (EMIT) {
                    sq += __int_as_float(__builtin_amdgcn_ds_bpermute((lane ^ 16) << 2, __float_as_int(sq)));
                    sq += __int_as_float(__builtin_amdgcn_ds_bpermute((lane ^ 32) << 2, __float_as_int(sq)));
                    if (fq == 0) ssq[row * 16 + u.pn * 4 + wc] = sq;
                }
            }
    }
};
struct EpiUp {
    static constexpr bool PERM = true, AFTER_DRAIN = false;
    bf16_t* O; const float* ssq;
    DI void operator()(const Acc& acc, const pg8::Unit& u, int wr, int wc, int fr_, int fq_) const {
        int fr = fr_, fq = fq_; asm volatile("" : "+v"(fr), "+v"(fq));
        const int t = u.pn / 11, colt = (u.pn - t * 11) * 256;
        bf16_t* base = O + (size_t)t * T * DFF;
        const int row0 = u.pm * 256 + wr * 64 + fr, lane = fq * 16 + fr;
        f32x4 part[2][4];
#pragma unroll
        for (int ai = 0; ai < 2; ++ai)
#pragma unroll
            for (int m = 0; m < 4; ++m) part[ai][m] = *(const f32x4*)(ssq + (size_t)(row0 + ai * 128 + m * 16) * 16 + fq * 4);
#pragma unroll
        for (int ai = 0; ai < 2; ++ai)
#pragma unroll
            for (int m = 0; m < 4; ++m) {
                const int row = row0 + ai * 128 + m * 16;
                float sq = (part[ai][m][0] + part[ai][m][1]) + (part[ai][m][2] + part[ai][m][3]);
                sq += __int_as_float(__builtin_amdgcn_ds_bpermute((lane ^ 16) << 2, __float_as_int(sq)));
                sq += __int_as_float(__builtin_amdgcn_ds_bpermute((lane ^ 32) << 2, __float_as_int(sq)));
                const float rstd = rsqrtf(sq * (1.f / DM) + NEPS);
                bf16_t* rowp = base + (size_t)row * DFF + colt + wc * 32 + 8 * fq;
#pragma unroll
                for (int bj = 0; bj < 2; ++bj) {
                    const f32x4 v0 = acc[ai][bj][m][0] * rstd, v1 = acc[ai][bj][m][1] * rstd;
                    u32x4 w; w.x = pk2(v0[0], v0[1]); w.y = pk2(v0[2], v0[3]); w.z = pk2(v1[0], v1[1]); w.w = pk2(v1[2], v1[3]);
                    *(u32x4*)(rowp + bj * 128) = w;
                }
            }
    }
};
struct EpiUpAct {
    static constexpr bool PERM = true, AFTER_DRAIN = false;
    bf16_t* act; const float* ssq; const float* cw; const float* cb; float* edge; PG8_LAS float* halo;
    DI void operator()(const Acc& acc, const pg8::Unit& u, int wr, int wc, int fr_, int fq_) const {
        int fr = fr_, fq = fq_; asm volatile("" : "+v"(fr), "+v"(fq));
        const int lane = fq * 16 + fr, fl = wc * 32 + 8 * fq, f0 = u.pn * 128 + fl;
        const int row0 = u.pm * 256 + wr * 64 + fr;
        float rstd[2][4];
        {
            f32x4 part[2][4];
#pragma unroll
            for (int ai = 0; ai < 2; ++ai)
#pragma unroll
                for (int m = 0; m < 4; ++m) part[ai][m] = *(const f32x4*)(ssq + (size_t)(row0 + ai * 128 + m * 16) * 16 + fq * 4);
#pragma unroll
            for (int ai = 0; ai < 2; ++ai)
#pragma unroll
                for (int m = 0; m < 4; ++m) {
                    float sq = (part[ai][m][0] + part[ai][m][1]) + (part[ai][m][2] + part[ai][m][3]);
                    sq += __int_as_float(__builtin_amdgcn_ds_bpermute((lane ^ 16) << 2, __float_as_int(sq)));
                    sq += __int_as_float(__builtin_amdgcn_ds_bpermute((lane ^ 32) << 2, __float_as_int(sq)));
                    rstd[ai][m] = rsqrtf(sq * (1.f / DM) + NEPS);
                }
        }
#pragma unroll
        for (int ai = 0; ai < 2; ++ai)
            if (fr >= 14) {
                PG8_LAS float* hp = halo + ((ai * 2 + wr) * 2 + (fr - 14)) * 128 + fl;
                *(PG8_LAS f32x4*)(hp) = acc[ai][0][3][0] * rstd[ai][3]; *(PG8_LAS f32x4*)(hp + 4) = acc[ai][0][3][1] * rstd[ai][3];
            }
        asm volatile("s_waitcnt lgkmcnt(0)" ::: "memory"); __builtin_amdgcn_s_barrier(); asm volatile("" ::: "memory");
        float w0[8], w1[8], w2[8], bb[8];
#pragma unroll
        for (int e = 0; e < 8; e += 4) { *(f32x4*)(w0 + e) = *(const f32x4*)(cw + f0 + e); *(f32x4*)(w1 + e) = *(const f32x4*)(cw + DFF + f0 + e); *(f32x4*)(w2 + e) = *(const f32x4*)(cw + 2 * DFF + f0 + e); *(f32x4*)(bb + e) = *(const f32x4*)(cb + f0 + e); }
        const int src1 = (((fr - 1) & 15) | (fq << 4)) << 2, src2 = (((fr - 2) & 15) | (fq << 4)) << 2;
#pragma unroll
        for (int ai = 0; ai < 2; ++ai) {
            float p1[8], p2[8];
            if (wr == 1 || ai == 1) {
                const PG8_LAS float* hb = halo + (((wr == 1 ? ai : 0) * 2 + (wr == 1 ? 0 : 1)) * 2) * 128 + fl;
                const f32x4 a0 = *(const PG8_LAS f32x4*)(hb), a1 = *(const PG8_LAS f32x4*)(hb + 4), b0 = *(const PG8_LAS f32x4*)(hb + 128), b1 = *(const PG8_LAS f32x4*)(hb + 132);
#pragma unroll
                for (int e = 0; e < 4; ++e) { p1[e] = b0[e]; p1[4 + e] = b1[e]; p2[e] = (fr == 0) ? a0[e] : b0[e]; p2[4 + e] = (fr == 0) ? a1[e] : b1[e]; }
            } else {
#pragma unroll
                for (int e = 0; e < 8; ++e) { p1[e] = 0.f; p2[e] = 0.f; }
            }
#pragma unroll
            for (int m = 0; m < 4; ++m) {
                const int row = row0 + ai * 128 + m * 16; const float rs = rstd[ai][m];
                float uu[8], gg[8], a[8];
#pragma unroll
                for (int e = 0; e < 4; ++e) { uu[e] = acc[ai][0][m][0][e] * rs; uu[4 + e] = acc[ai][0][m][1][e] * rs; gg[e] = acc[ai][1][m][0][e] * rs; gg[4 + e] = acc[ai][1][m][1][e] * rs; }
#pragma unroll
                for (int e = 0; e < 8; ++e) {
                    const float c1 = __int_as_float(__builtin_amdgcn_ds_bpermute(src1, __float_as_int(uu[e])));
                    const float c2 = __int_as_float(__builtin_amdgcn_ds_bpermute(src2, __float_as_int(uu[e])));
                    const float u1 = (fr >= 1) ? c1 : p1[e], u2 = (fr >= 2) ? c2 : p2[e];
                    p1[e] = c1; p2[e] = c2;
                    a[e] = siluf_(bb[e] + w0[e] * uu[e] + w1[e] * u1 + w2[e] * u2) * gg[e];
                }
                *(u32x4*)(act + (size_t)row * DFF + f0) = pack8(a);
                if (ai == 0 && m == 0 && wr == 0 && fr < 2) {
                    float* e2 = edge + (size_t)(u.pm * 6 + 2 + fr) * DFF + f0; float* e4 = edge + (size_t)(u.pm * 6 + 4 + fr) * DFF + f0;
                    *(f32x4*)(e2) = *(f32x4*)uu; *(f32x4*)(e2 + 4) = *(f32x4*)(uu + 4); *(f32x4*)(e4) = *(f32x4*)gg; *(f32x4*)(e4 + 4) = *(f32x4*)(gg + 4);
                }
                if (ai == 1 && m == 3 && wr == 1 && fr >= 14) {
                    float* e0 = edge + (size_t)(u.pm * 6 + (fr - 14)) * DFF + f0;
                    *(f32x4*)(e0) = *(f32x4*)uu; *(f32x4*)(e0 + 4) = *(f32x4*)(uu + 4);
                }
            }
        }
    }
};
DI void ffn_edge_fixup(const Ctx& C, int pm) {
    if ((pm & 15) == 0) return;
    const int L = C.layer;
    const float* cw = C.in(27) + (size_t)L * 3 * DFF; const float* cb = C.in(28) + (size_t)L * DFF;
    const float* cur = (const float*)(C.ws + WS_EDGE) + (size_t)pm * 6 * DFF; const float* prev = cur - 6 * DFF;
    bf16_t* act = (bf16_t*)(C.ws + WS_ACT);
    for (int idx = C.tid; idx < 2 * DFF; idx += 512) {
        const int i = idx >= DFF ? 1 : 0, f = idx - i * DFF;
        const float u0 = cur[(2 + i) * DFF + f], u1 = i ? cur[2 * DFF + f] : prev[DFF + f], u2 = i ? prev[DFF + f] : prev[f], g = cur[(4 + i) * DFF + f];
        const float v = cb[f] + cw[f] * u0 + cw[DFF + f] * u1 + cw[2 * DFF + f] * u2;
        act[(size_t)(pm * 256 + i) * DFF + f] = f2bf(siluf_(v) * g);
    }
}
DI void transpose_item(const float* W, int K, int Nsrc, int c0, int ncols, bf16_t* WT, int row0, int permq, float* scr, int item, int lane, const float* ksc) {
    const int nblk = (ncols + 31) >> 5, kb = item / nblk, nb = item - kb * nblk, k0 = 64 * kb, n0 = 32 * nb;
    const int ncol = n0 + (lane & 31);
#pragma unroll 8
    for (int i = 0; i < 32; ++i) { const int kk = 2 * i + (lane >> 5); const float sc = ksc ? ksc[k0 + kk] : 1.f; scr[kk * 33 + (lane & 31)] = (ncol < ncols) ? W[(size_t)(k0 + kk) * Nsrc + c0 + ncol] * sc : 0.f; }
    LDS_FENCE();
    const int c = lane & 7;
#pragma unroll
    for (int j = 0; j < 4; ++j) {
        const int n = (lane >> 3) + 8 * j, col = n0 + n;
        if (col < ncols) {
            int lr = col;
            if (col < permq) { const int jl = col & 255; lr = (col & ~255) + ((jl >> 5) & 1) * 128 + (jl >> 6) * 32 + (jl & 31); }
            if (permq == -2) { const int isg = col >= DFF ? 1 : 0, f = col - isg * DFF; lr = (f >> 7) * 256 + isg * 128 + (f & 127); }
            if (permq == -1) { const int n = col >> 10, d = col & 1023, dl = d & 63; lr = (d >> 6) * 256 + 128 * (n >> 1) + 32 * (dl >> 4) + 8 * ((dl >> 2) & 3) + 4 * (n & 1) + (dl & 3); }
            const float* s = scr + (8 * c) * 33 + n;
            u32x4 o; o.x = pk2(s[0 * 33], s[1 * 33]); o.y = pk2(s[2 * 33], s[3 * 33]); o.z = pk2(s[4 * 33], s[5 * 33]); o.w = pk2(s[6 * 33], s[7 * 33]);
            *(u32x4*)(WT + (size_t)(row0 + lr) * K + k0 + 8 * c) = o;
        }
    }
    LDS_FENCE();
}
DI void rmsnorm_rows_bf16(const Ctx& C, const float* x, const float* w, bf16_t* o) {
    const int gw = C.bid * 8 + C.wave, NGW = C.G * 8;
    f32x4 wv[4];
#pragma unroll
    for (int j = 0; j < 4; ++j) wv[j] = *(const f32x4*)(w + 4 * C.lane + 256 * j);
    for (int m = gw; m < T; m += 2 * NGW) {
        const int m2 = m + NGW; const bool two = m2 < T;
        const float* xr = x + (size_t)m * DM + 4 * C.lane; const float* xr2 = x + (size_t)(two ? m2 : m) * DM + 4 * C.lane;
        f32x4 v[4], u[4]; float s = 0.f, s2 = 0.f;
#pragma unroll
        for (int j = 0; j < 4; ++j) { v[j] = *(const f32x4*)(xr + 256 * j); u[j] = *(const f32x4*)(xr2 + 256 * j); }
        asm volatile("" ::: "memory");
#pragma unroll
        for (int j = 0; j < 4; ++j) { s += (v[j][0] * v[j][0] + v[j][1] * v[j][1]) + (v[j][2] * v[j][2] + v[j][3] * v[j][3]); s2 += (u[j][0] * u[j][0] + u[j][1] * u[j][1]) + (u[j][2] * u[j][2] + u[j][3] * u[j][3]); }
        const float rstd = rsqrtf(wave_sum(s) * (1.f / DM) + NEPS), rstd2 = rsqrtf(wave_sum(s2) * (1.f / DM) + NEPS);
        bf16_t* orow = o + (size_t)m * DM + 4 * C.lane;
#pragma unroll
        for (int j = 0; j < 4; ++j) { u32x2 pk; pk.x = pk2(v[j][0] * rstd * wv[j][0], v[j][1] * rstd * wv[j][1]); pk.y = pk2(v[j][2] * rstd * wv[j][2], v[j][3] * rstd * wv[j][3]); *(u32x2*)(orow + 256 * j) = pk; }
        if (two) {
            bf16_t* orow2 = o + (size_t)m2 * DM + 4 * C.lane;
#pragma unroll
            for (int j = 0; j < 4; ++j) { u32x2 pk; pk.x = pk2(u[j][0] * rstd2 * wv[j][0], u[j][1] * rstd2 * wv[j][1]); pk.y = pk2(u[j][2] * rstd2 * wv[j][2], u[j][3] * rstd2 * wv[j][3]); *(u32x2*)(orow2 + 256 * j) = pk; }
        }
    }
}
constexpr int CI0 = 16 * 56, CIa = 16, CI1 = 16 * 28, CI2 = 16 * 72, CI3 = 16 * 128, CI4 = 4 * 32, CI8 = 16 * 32, CI9 = 16 * 176, CI10 = 44 * 32;
constexpr int CONV_WZ = CI0 + CIa + CI1 + CI2, CONV_REST = CI3 + 4 * CI4 + CI8 + CI9 + CI10;
DI void conv_item(const Ctx& C, int LW, int set, int it, float* scr) {
    const float* W; const float* ksc = nullptr; int K = 1024, Nsrc = NIN, c0 = 0, ncols, row0 = 0, permq = 0; size_t dst; int r = it;
    if (set == 0) {
        W = C.in(4) + (size_t)LW * DM * NIN; dst = WS_WZ;
        if (r < CI0) { ncols = ZAW; }
        else if (r < CI0 + CIa) { r -= CI0; c0 = 1792; ncols = 16; row0 = ZAW + 896; }
        else if (r < CI0 + CIa + CI1) { r -= CI0 + CIa; c0 = 1808; ncols = 896; row0 = ZAW; }
        else { r -= CI0 + CIa + CI1; c0 = 2704; ncols = 2304; row0 = ZAW + 1024; permq = 1536; }
    } else if (r < CI3) { W = C.in(4) + (size_t)LW * DM * NIN; dst = WS_WG; c0 = 5008; ncols = 4096; permq = -1; }
    else if (r < CI3 + 4 * CI4) { r -= CI3; const int n = r / CI4; r -= n * CI4; W = C.in(24) + (size_t)LW * 4 * 256 * 1024 + (size_t)n * 256 * 1024; K = 256; Nsrc = 1024; ncols = 1024; dst = WS_WB; row0 = n * 1024; }
    else if (r < CI3 + 4 * CI4 + CI8) { r -= CI3 + 4 * CI4; W = C.in(25) + (size_t)LW * DM * DM; Nsrc = 1024; ncols = 1024; dst = WS_WO; }
    else if (r < CI3 + 4 * CI4 + CI8 + CI9) { r -= CI3 + 4 * CI4 + CI8; W = C.in(26) + (size_t)LW * DM * 2 * DFF; Nsrc = 2 * DFF; ncols = 2 * DFF; dst = WS_WUP; ksc = C.in(2) + LW * DM; permq = -2; }
    else { r -= CI3 + 4 * CI4 + CI8 + CI9; W = C.in(29) + (size_t)LW * DFF * DM; K = DFF; Nsrc = 1024; ncols = 1024; dst = WS_WDN; }
    transpose_item(W, K, Nsrc, c0, ncols, (bf16_t*)(C.ws + dst), row0, permq, scr, r, C.lane, ksc);
}
DI void phase_A(const Ctx& C) {
    const int L = C.layer;
    float* scr = (float*)(C.lds + C.wave * 16384);
    const int gw = C.bid * 8 + C.wave, NGW = C.G * 8;
    bf16_t* WZ = (bf16_t*)(C.ws + WS_WZ);
    if (L == 0) {
        for (int it = gw; it < CONV_WZ; it += NGW) conv_item(C, 0, 0, it, scr);
    for (int i = C.bid * 512 + C.tid; i < 112 * 128; i += C.G * 512) {
        const int rr = i >> 7, ch = i & 127; const int row = ZAW + 912 + rr;
        *(u32x4*)(WZ + (size_t)row * 1024 + ch * 8) = (u32x4){0u, 0u, 0u, 0u};
    }
        float* rc = (float*)(C.ws + WS_ROPEC); float* rs = (float*)(C.ws + WS_ROPES);
        for (int i = C.bid * 512 + C.tid; i < SEQ * 32; i += C.G * 512) {
            const int pos = i >> 5, j = i & 31;
            const float inv = (float)pow(10000.0, -(double)j / 32.0);
            const float ang = (float)pos * inv;
            rc[i] = cosf(ang); rs[i] = sinf(ang);
        }
    }
    const float* x = (L == 0) ? C.in(0) : C.p->out;
    rmsnorm_rows_bf16(C, x, C.in(1) + L * DM, (L == 0) ? (bf16_t*)C.p->out : (bf16_t*)(C.ws + WS_XN));
}

DI bf16_t* rw_slot(const Ctx& C, int s) { return (bf16_t*)(C.ws + WS_RW + (size_t)s * SLOT); }
DI void phase_C(const Ctx& C) {
    const int L = C.layer;
    float* zs = (float*)C.lds;
    float* vv1 = zs + 16 * 896;
    const bf16_t* ZR = (const bf16_t*)(C.ws + WS_OM);
    const float* mu = C.in(10) + L * 896;
    const float* w0 = C.in(11) + L * 256; const float* w2 = C.in(12) + L * 32 * 256;
    const float* a0 = C.in(13) + L * 256; const float* a2 = C.in(14) + L * 32 * 256;
    const float* g2 = C.in(15) + L * 64 * 256;
    const float* k_k = C.in(16) + L * 256; const float* k_a = C.in(17) + L * 256; const float* r_k = C.in(18) + L * 256;
    const float* v0 = C.in(21); const float* v1 = C.in(22); const float* v2 = C.in(23);
    bf16_t* Sg = rw_slot(C, 0); bf16_t* Sr = rw_slot(C, 2); bf16_t* Sw = rw_slot(C, 3); bf16_t* Sk = rw_slot(C, 4); bf16_t* Skk = rw_slot(C, 5); bf16_t* Sb = rw_slot(C, 6);
    bf16_t* VRW = (bf16_t*)(C.ws + WS_VRW); float* BON = (float*)(C.ws + WS_BONUS);
    const int c = C.tid & 255, th = C.tid >> 8, h = c >> 6;
    const float cw0 = w0[c], ca0 = a0[c], ckk = k_k[c], cka = k_a[c], crk = r_k[c], cv0 = (L > 0) ? v0[c] : 0.f;
    float* OUT = vv1 + 16 * 32;
    const int l15 = C.lane & 15, k8 = (C.lane >> 4) * 8;
    bf16x8 Bw[2], Ba[2], Bg[2][2], Bv2[2], Bv1[2];
#pragma unroll
    for (int cb = 0; cb < 2; ++cb) {
        const int col = C.wave * 32 + cb * 16 + l15; float f[8];
#pragma unroll
        for (int e = 0; e < 8; ++e) f[e] = w2[(k8 + e) * 256 + col];
        Bw[cb] = __builtin_bit_cast(bf16x8, pack8(f));
#pragma unroll
        for (int e = 0; e < 8; ++e) f[e] = a2[(k8 + e) * 256 + col];
        Ba[cb] = __builtin_bit_cast(bf16x8, pack8(f));
#pragma unroll
        for (int ks = 0; ks < 2; ++ks) {
#pragma unroll
            for (int e = 0; e < 8; ++e) f[e] = g2[(ks * 32 + k8 + e) * 256 + col];
            Bg[cb][ks] = __builtin_bit_cast(bf16x8, pack8(f));
        }
#pragma unroll
        for (int e = 0; e < 8; ++e) f[e] = (L > 0) ? v2[(k8 + e) * 256 + col] : 0.f;
        Bv2[cb] = __builtin_bit_cast(bf16x8, pack8(f));
#pragma unroll
        for (int e = 0; e < 8; ++e) f[e] = (L > 0) ? v1[(C.wave * 32 + k8 + e) * 32 + cb * 16 + l15] : 0.f;
        Bv1[cb] = __builtin_bit_cast(bf16x8, pack8(f));
    }
    for (int tile = C.bid; tile < T / 16; tile += C.G) {
        const int t0 = tile * 16;
        __syncthreads();
        {
            const int tok = C.tid >> 5, c4 = (C.tid & 31) * 4; const size_t t = (size_t)(t0 + tok);
            float al[16]; unpack8(*(const u32x4*)(ZR + t * 1024 + 896), al); unpack8(*(const u32x4*)(ZR + t * 1024 + 904), al + 8);
            const float* aw2 = C.in(7) + L * 16 * 128; const float* ab = C.in(8) + L * 128;
            f32x4 x = *(const f32x4*)(ab + c4);
#pragma unroll
            for (int j = 0; j < 16; ++j) x += al[j] * *(const f32x4*)(aw2 + j * 128 + c4);
            float la[4];
#pragma unroll
            for (int e = 0; e < 4; ++e) la[e] = (fminf(x[e], 0.f) - __logf(1.f + __expf(-fabsf(x[e])))) * 0.0625f;
            u32x2 w; w.x = pk2(la[0], la[1]); w.y = pk2(la[2], la[3]);
            *(u32x2*)(rw_slot(C, 1) + t * 128 + c4) = w;
        }
        {
            u32x4 zr[4], zq[4];
#pragma unroll
            for (int i = 0; i < 4; ++i) {
                const int idx = C.tid + 512 * i; zr[i] = (u32x4){0u, 0u, 0u, 0u}; zq[i] = zr[i];
                if (idx < 16 * 112) { const int tok = idx / 112, ch = idx - tok * 112, t = t0 + tok;
                    zr[i] = *(const u32x4*)(ZR + (size_t)t * 1024 + ch * 8);
                    if ((t & (SEQ - 1)) != 0) zq[i] = *(const u32x4*)(ZR + (size_t)(t - 1) * 1024 + ch * 8); }
            }
#pragma unroll
            for (int i = 0; i < 4; ++i) {
                const int idx = C.tid + 512 * i;
                if (idx < 16 * 112) {
                    const int tok = idx / 112, ch = idx - tok * 112, col = ch * 8;
                    float z[8], zp[8], m[8];
                    unpack8(zr[i], z); unpack8(zq[i], zp);
                    *(f32x4*)m = *(const f32x4*)(mu + col); *(f32x4*)(m + 4) = *(const f32x4*)(mu + col + 4);
#pragma unroll
                    for (int e = 0; e < 8; ++e) {
                        float v = z[e] + m[e] * (zp[e] - z[e]);
                        if (col >= 256 && col < 288) v = 1.f - 2.f * __builtin_amdgcn_rcpf(1.f + __expf(2.f * v));
                        if (col >= 832) v = sigmoidf_(v);
                        zs[tok * 896 + col + e] = v;
                    }
                }
            }
        }
        __syncthreads();
        const f32x4 zero4 = (f32x4){0.f, 0.f, 0.f, 0.f};
        const float* zrow = zs + l15 * 896 + k8;
#define AFRAG(p) __builtin_bit_cast(bf16x8, pack8(p))
        if (L > 0) {
            float* P = OUT + C.wave * 512;
            const bf16x8 av_ = AFRAG(zrow + 544 + C.wave * 32);
#pragma unroll
            for (int cb = 0; cb < 2; ++cb) {
                const f32x4 r = __builtin_amdgcn_mfma_f32_16x16x32_bf16(av_, Bv1[cb], zero4, 0, 0, 0);
#pragma unroll
                for (int j = 0; j < 4; ++j) P[((C.lane >> 4) * 4 + j) * 32 + cb * 16 + l15] = r[j];
            }
            __syncthreads();
            { float a = 0.f;
#pragma unroll
              for (int w = 0; w < 8; ++w) a += OUT[w * 512 + C.tid]; vv1[C.tid] = a; }
        }
        __syncthreads();
        {
            const bf16x8 a_w = AFRAG(zrow + 256), a_a = AFRAG(zrow + 800), a_g0 = AFRAG(zrow + 832), a_g1 = AFRAG(zrow + 864), a_v = AFRAG(vv1 + l15 * 32 + k8);
#pragma unroll
            for (int cb = 0; cb < 2; ++cb) {
                const f32x4 rw = __builtin_amdgcn_mfma_f32_16x16x32_bf16(a_w, Bw[cb], zero4, 0, 0, 0);
                const f32x4 ra = __builtin_amdgcn_mfma_f32_16x16x32_bf16(a_a, Ba[cb], zero4, 0, 0, 0);
                f32x4 rg = __builtin_amdgcn_mfma_f32_16x16x32_bf16(a_g0, Bg[cb][0], zero4, 0, 0, 0);
                rg = __builtin_amdgcn_mfma_f32_16x16x32_bf16(a_g1, Bg[cb][1], rg, 0, 0, 0);
                const f32x4 rv = __builtin_amdgcn_mfma_f32_16x16x32_bf16(a_v, Bv2[cb], zero4, 0, 0, 0);
                const int col = C.wave * 32 + cb * 16 + l15;
#pragma unroll
                for (int j = 0; j < 4; ++j) { float* o = OUT + (((C.lane >> 4) * 4 + j) * 4) * 256 + col; o[0] = rw[j]; o[256] = ra[j]; o[512] = rg[j]; o[768] = rv[j]; }
            }
        }
#undef AFRAG
        __syncthreads();
        float aw[8], aa[8], ag[8], av[8];
        const float* zb = zs + (th * 8) * 896;
#pragma unroll
        for (int q = 0; q < 8; ++q) { const float* o = OUT + ((th * 8 + q) * 4) * 256 + c; aw[q] = cw0 + o[0]; aa[q] = ca0 + o[256]; ag[q] = o[512]; av[q] = cv0 + o[768]; }
        float vf8[8];
#pragma unroll
        for (int q = 0; q < 8; ++q) vf8[q] = (L > 0) ? bf2f(VRW[(size_t)(t0 + th * 8 + q) * 256 + c]) : 0.f;
#pragma unroll
        for (int q = 0; q < 8; ++q) {
            const int t = t0 + th * 8 + q; const size_t o = (size_t)t * 256 + c;
            const float xw = -aw[q];
            const float sp = fmaxf(xw, 0.f) + __logf(1.f + __expf(-fabsf(xw)));
            const float wr = -sp - 0.5f;
            const float lw = -__expf(wr);
            const float a = sigmoidf_(aa[q]);
            const float r = zb[q * 896 + c], k = zb[q * 896 + 288 + c];
            float v = zb[q * 896 + 544 + c];
            if (L > 0) { const float vf = vf8[q]; v = v + (vf - v) * sigmoidf_(av[q]); }
            const float kkr = k * ckk;
            const float ss = wave_sum(kkr * kkr);
            const float kk = kkr * rsqrtf(fmaxf(ss, 1e-24f));
            const float km = k * (1.f + (a - 1.f) * cka);
            const float bon = wave_sum(r * km * crk);
            Sg[o] = f2bf(ag[q]); Sr[o] = f2bf(r); Sw[o] = f2bf(lw); Sk[o] = f2bf(km); Skk[o] = f2bf(kk); Sb[o] = f2bf(kk * a); VRW[o] = f2bf(v);
            if (C.lane == 0) BON[t * 4 + h] = bon;
        }
    }
    __syncthreads();
}
template <int MODE> struct ScanCfg {
    static constexpr int DK = (MODE == 1) ? 32 : 64, NKG = DK / 4, RPW = 64 / NKG, NVB = 4 * RPW, NARR = (MODE == 2) ? 5 : 3, TC = 32, NPARTS = 64 / NVB;
    static constexpr int NP = NKG / 4;
    static constexpr int ARR_F = TC * DK, BUF_F = NARR * ARR_F + TC * NVB + TC * NVB * NP;
};
struct StageRegs { u32x4 a[5]; u32x4 v; };
template <int MODE> DI void scan_load(const Ctx& C, StageRegs& R, int row0  , int h, int vp, int t2) {
    if (MODE == 2) {
        const int step = t2 >> 3, kc = t2 & 7; const size_t go = (size_t)(row0 + step) * 256 + h * 64 + kc * 8;
#pragma unroll
        for (int i = 0; i < 5; ++i) R.a[i] = *(const u32x4*)(rw_slot(C, 2 + i) + go);
        if (t2 < 64) { const int st = t2 >> 1, hf = t2 & 1; R.v = *(const u32x4*)((const bf16_t*)(C.ws + WS_VRW) + (size_t)(row0 + st) * 256 + h * 64 + vp * 16 + hf * 8); }
    } else if (MODE == 0) {
        const bf16_t* ZA = (const bf16_t*)(C.ws + WS_ZA);
        const int step = t2 >> 3, kc = t2 & 7; const size_t go = (size_t)(row0 + step) * ZAW + h * 64 + kc * 8;
        R.a[0] = *(const u32x4*)(ZA + go); R.a[1] = *(const u32x4*)(ZA + go + 256);
        if (t2 < 64) { const int st = t2 >> 1, hf = t2 & 1; R.v = *(const u32x4*)(ZA + (size_t)(row0 + st) * ZAW + 512 + h * 64 + vp * 16 + hf * 8); }
    } else {
        const bf16_t* ZA = (const bf16_t*)(C.ws + WS_ZA);
        const int step = t2 >> 3, k4 = (t2 & 7) * 4; const size_t ro = (size_t)(row0 + step) * ZAW;
        const u32x2 qw = *(const u32x2*)(ZA + ro + 1024 + h * 32 + k4), kw = *(const u32x2*)(ZA + ro + 1152 + h * 32 + k4);
        const u32x2 la = *(const u32x2*)(rw_slot(C, 1) + (size_t)(row0 + step) * 128 + h * 32 + k4);
        R.a[0] = (u32x4){qw.x, qw.y, kw.x, kw.y}; R.a[1] = (u32x4){la.x, la.y, 0u, 0u};
        if (t2 < 128) { const int st = t2 >> 2, qd = t2 & 3; R.v = *(const u32x4*)(ZA + (size_t)(row0 + st) * ZAW + 1280 + h * 64 + vp * 32 + qd * 8); }
    }
}
template <int MODE> DI void scan_commit(const Ctx& C, const StageRegs& R, float* buf, int h, int t2, const float* lbv) {
    typedef ScanCfg<MODE> S;
    float* V = buf + S::NARR * S::ARR_F;
    if (MODE == 2) {
        const int step = t2 >> 3, kc = t2 & 7; float* d = buf + step * 64 + kc * 8;
#pragma unroll
        for (int i = 0; i < 5; ++i) {
            float f[8]; unpack8(R.a[i], f);
            if (i == 1) {
#pragma unroll
                for (int e = 0; e < 8; ++e) f[e] = __expf(f[e]);
            }
            *(f32x4*)(d + i * S::ARR_F) = *(f32x4*)f; *(f32x4*)(d + i * S::ARR_F + 4) = *(f32x4*)(f + 4);
        }
        if (t2 < 64) { const int st = t2 >> 1, hf = t2 & 1; float f[8]; unpack8(R.v, f); *(f32x4*)(V + st * 16 + hf * 8) = *(f32x4*)f; *(f32x4*)(V + st * 16 + hf * 8 + 4) = *(f32x4*)(f + 4); }
    } else if (MODE == 0) {
        const int step = t2 >> 3, kc = t2 & 7; float* d = buf + step * 64 + kc * 8;
        float q[8], f[8], g[8], k[8];
        unpack8(R.a[0], q); unpack8(R.a[1], f);
#pragma unroll
        for (int e = 0; e < 8; ++e) { q[e] = siluf_(q[e]); g[e] = lbv[e] + (1.f - lbv[e]) * sigmoidf_(f[e]); k[e] = 1.f - g[e]; }
        *(f32x4*)(d) = *(f32x4*)q; *(f32x4*)(d + 4) = *(f32x4*)(q + 4);
        *(f32x4*)(d + S::ARR_F) = *(f32x4*)g; *(f32x4*)(d + S::ARR_F + 4) = *(f32x4*)(g + 4);
        *(f32x4*)(d + 2 * S::ARR_F) = *(f32x4*)k; *(f32x4*)(d + 2 * S::ARR_F + 4) = *(f32x4*)(k + 4);
        if (t2 < 64) { const int st = t2 >> 1, hf = t2 & 1; unpack8(R.v, f); *(f32x4*)(V + st * 16 + hf * 8) = *(f32x4*)f; *(f32x4*)(V + st * 16 + hf * 8 + 4) = *(f32x4*)(f + 4); }
    } else {
        const int step = t2 >> 3, k4 = (t2 & 7) * 4; float* d = buf + step * 32 + k4;
        const u32x4 lw_ = R.a[1];
        const f32x4 a = (f32x4){__expf(bflo(lw_.x)), __expf(bfhi(lw_.x)), __expf(bflo(lw_.y)), __expf(bfhi(lw_.y))};
        const float sc = 0.17677669529663687f;
        const u32x4 w = R.a[0];
        *(f32x4*)(d) = (f32x4){bflo(w.x) * sc, bfhi(w.x) * sc, bflo(w.y) * sc, bfhi(w.y) * sc};
        *(f32x4*)(d + S::ARR_F) = a;
        *(f32x4*)(d + 2 * S::ARR_F) = (f32x4){bflo(w.z), bfhi(w.z), bflo(w.w), bfhi(w.w)};
        if (t2 < 128) { const int st = t2 >> 2, qd = t2 & 3; float f[8]; unpack8(R.v, f); *(f32x4*)(V + st * 32 + qd * 8) = *(f32x4*)f; *(f32x4*)(V + st * 32 + qd * 8 + 4) = *(f32x4*)(f + 4); }
    }
}
template <int MODE> DI void scan_store(const Ctx& C, const float* buf, int row0, int h, int vp, int t2) {
    typedef ScanCfg<MODE> S;
    const float* O = buf + S::NARR * S::ARR_F + S::TC * S::NVB;
    bf16_t* OM = (bf16_t*)(C.ws + WS_OM) + (size_t)(MODE == 0 ? 0 : MODE == 1 ? 1 : 2) * T * 256;
    constexpr int CPS = S::NVB / 8;
    if (t2 < S::TC * CPS) { const int st = t2 / CPS, q = t2 % CPS; float f[8];
#pragma unroll
        for (int e = 0; e < 8; ++e) { const float* pp = O + ((st * S::NVB + q * 8 + e) * S::NP); float a = pp[0];
#pragma unroll
            for (int i = 1; i < S::NP; ++i) a += pp[i];
            f[e] = a; }
        *(u32x4*)(OM + (size_t)(row0 + st) * 256 + h * 64 + vp * S::NVB + q * 8) = pack8(f); }
}
template <int MODE> DI void scan_item(const Ctx& C, int sub) {
    typedef ScanCfg<MODE> S;
    const int bh = sub / S::NPARTS, vp = sub % S::NPARTS, b = bh >> 2, h = bh & 3;
    float* base = (float*)C.lds;
    const int t2 = C.tid - 256, rowbase = b * SEQ;
    constexpr int NC = SEQ / S::TC;
    float lbv[8];
#pragma unroll
    for (int e = 0; e < 8; ++e) lbv[e] = 0.f;
    if (MODE == 0 && C.layer > 0 && C.wave >= 4) {
        const float* tab = C.in(5); const int kc = t2 & 7;
#pragma unroll
        for (int e = 0; e < 8; ++e) { const int cc = h * 64 + kc * 8 + e; lbv[e] = sigmoidf_(tab[256 + cc] - tab[cc]); }
    }
    __syncthreads();
    StageRegs R;
    if (C.wave >= 4) { scan_load<MODE>(C, R, rowbase, h, vp, t2); scan_commit<MODE>(C, R, base, h, t2, lbv); scan_load<MODE>(C, R, rowbase + S::TC, h, vp, t2); }
    __syncthreads();
    typedef float f32x2v __attribute__((ext_vector_type(2)));
    f32x2v s01 = (f32x2v){0.f, 0.f}, s23 = (f32x2v){0.f, 0.f};
    const int kg = C.lane % S::NKG, row = C.wave * S::RPW + C.lane / S::NKG;
    for (int c = 0; c < NC; ++c) {
        float* cur = base + (c & 1) * S::BUF_F; float* nxt = base + ((c + 1) & 1) * S::BUF_F;
        if (C.wave >= 4) {
            if (c > 0) scan_store<MODE>(C, nxt, rowbase + (c - 1) * S::TC, h, vp, t2);
            if (c + 1 < NC) scan_commit<MODE>(C, R, nxt, h, t2, lbv);
            if (c + 2 < NC) scan_load<MODE>(C, R, rowbase + (c + 2) * S::TC, h, vp, t2);
        } else {
            const float* Q = cur + kg * 4; const float* V = cur + S::NARR * S::ARR_F + row;
            float* O = ((kg & 3) == 0) ? (cur + S::NARR * S::ARR_F + S::TC * S::NVB + row * S::NP + (kg >> 2)) : ((float*)(C.lds + LDS_MISC + 4096) + C.tid);
            f32x4 qn = *(const f32x4*)(Q), an = *(const f32x4*)(Q + S::ARR_F), kn = *(const f32x4*)(Q + 2 * S::ARR_F), kkn, bbn;
            f32x4 qm = *(const f32x4*)(Q + S::DK), am = *(const f32x4*)(Q + S::ARR_F + S::DK), km = *(const f32x4*)(Q + 2 * S::ARR_F + S::DK), kkm, bbm;
            if (MODE == 2) { kkn = *(const f32x4*)(Q + 3 * S::ARR_F); bbn = *(const f32x4*)(Q + 4 * S::ARR_F); kkm = *(const f32x4*)(Q + 3 * S::ARR_F + S::DK); bbm = *(const f32x4*)(Q + 4 * S::ARR_F + S::DK); }
            float vn = V[0], vm = V[S::NVB];
#pragma unroll
            for (int t = 0; t < S::TC; ++t) {
                const f32x4 q = qn, a = an, k = kn, kk = kkn, bb = bbn; const float v = vn;
                qn = qm; an = am; kn = km; kkn = kkm; bbn = bbm; vn = vm;
                if (t + 2 < S::TC) {
                    qm = *(const f32x4*)(Q + (t + 2) * S::DK); am = *(const f32x4*)(Q + S::ARR_F + (t + 2) * S::DK); km = *(const f32x4*)(Q + 2 * S::ARR_F + (t + 2) * S::DK);
                    if (MODE == 2) { kkm = *(const f32x4*)(Q + 3 * S::ARR_F + (t + 2) * S::DK); bbm = *(const f32x4*)(Q + 4 * S::ARR_F + (t + 2) * S::DK); }
                    vm = V[(t + 2) * S::NVB];
                }
#define LO2(x) __builtin_shufflevector(x, x, 0, 1)
#define HI2(x) __builtin_shufflevector(x, x, 2, 3)
                const f32x2v vv = (f32x2v){v, v};
                if (MODE == 2) {
                    f32x2v p = s01 * LO2(kk); p = s23 * HI2(kk) + p;
                    float sa = p.x + p.y;
                    const f32x2v t01 = s01 * LO2(a) + vv * LO2(k), t23 = s23 * HI2(a) + vv * HI2(k);
                    sa = -grp_sum<S::NKG>(sa);
                    const f32x2v sav = (f32x2v){sa, sa};
                    s01 = sav * LO2(bb) + t01; s23 = sav * HI2(bb) + t23;
                } else {
                    s01 = s01 * LO2(a) + vv * LO2(k); s23 = s23 * HI2(a) + vv * HI2(k);
                }
                f32x2v yp = s01 * LO2(q); yp = s23 * HI2(q) + yp;
                float y = yp.x + yp.y;
                y += dpp_mov<0xB1>(y); y += dpp_mov<0x4E>(y);
                O[t * S::NVB * S::NP] = y;
            }
        }
        __syncthreads();
    }
    if (C.wave >= 4) scan_store<MODE>(C, base + ((NC - 1) & 1) * S::BUF_F, rowbase + (NC - 1) * S::TC, h, vp, t2);
    __syncthreads();
}

template <bool NOSTORE> DI void attn_item(const Ctx& C, int item) {
    const int qb = item & 31; int r = item >> 5; const int h = r & 3; r >>= 2; const int g = r % 3, b = r / 3;
    const int dil = (g == 0) ? 1 : (g == 1) ? 4 : 16, nqb = 32 / dil;
    const int rho = qb / nqb, i0 = (qb % nqb) * 128;
    bf16_t* ZT = (bf16_t*)(C.ws + WS_ZT); float* LSE = (float*)(C.ws + WS_LSE);
    bf16_t* Ks = (bf16_t*)C.lds;
    bf16_t* Vt = Ks + 256 * 72;
    bf16_t* Ps = Vt + 64 * 280 + C.wave * 16 * 168;
    const size_t rowbase = (size_t)b * SEQ; const int qcol = g * 256 + h * 64;
    __syncthreads();
    for (int idx = C.tid; idx < 2048; idx += 512) {
        const int key = idx >> 3, ch = idx & 7, ki = i0 - 128 + key;
        u32x4 kv = (u32x4){0u, 0u, 0u, 0u}, vv = kv;
        if (ki >= 0) { const bf16_t* src = ZT + (rowbase + (size_t)ki * dil + rho) * 2304 + qcol + ch * 8; kv = *(const u32x4*)(src + 768); vv = *(const u32x4*)(src + 1536); }
        *(u32x4*)(Ks + key * 72 + ch * 8) = kv;
        bf16_t* vd = Vt + (ch * 8) * 280 + key;
        vd[0 * 280] = (bf16_t)(vv.x & 0xffff); vd[1 * 280] = (bf16_t)(vv.x >> 16); vd[2 * 280] = (bf16_t)(vv.y & 0xffff); vd[3 * 280] = (bf16_t)(vv.y >> 16);
        vd[4 * 280] = (bf16_t)(vv.z & 0xffff); vd[5 * 280] = (bf16_t)(vv.z >> 16); vd[6 * 280] = (bf16_t)(vv.w & 0xffff); vd[7 * 280] = (bf16_t)(vv.w >> 16);
    }
    for (int idx = C.tid; idx < 64 * 24; idx += 512) Vt[(idx / 24) * 280 + 256 + idx % 24] = 0;
    for (int idx = C.lane; idx < 16 * 16; idx += 64) Ps[(idx >> 4) * 168 + 144 + (idx & 15)] = 0;
    const int l15 = C.lane & 15, l4 = C.lane >> 4, w16 = C.wave * 16;
    bf16x8 qa0, qa1;
    { const size_t tq = rowbase + (size_t)(i0 + w16 + l15) * dil + rho; const bf16_t* qp = ZT + tq * 2304 + qcol; qa0 = *(const bf16x8*)(qp + l4 * 8); qa1 = *(const bf16x8*)(qp + 32 + l4 * 8); }
    __syncthreads();
    f32x4 s[9];
#pragma unroll
    for (int kb = 0; kb < 9; ++kb) {
        const bf16_t* kp = Ks + (w16 + kb * 16 + l15) * 72 + l4 * 8;
        const bf16x8 k0 = *(const bf16x8*)kp, k1 = *(const bf16x8*)(kp + 32);
        f32x4 z = (f32x4){0.f, 0.f, 0.f, 0.f};
        z = __builtin_amdgcn_mfma_f32_16x16x32_bf16(qa0, k0, z, 0, 0, 0);
        s[kb] = __builtin_amdgcn_mfma_f32_16x16x32_bf16(qa1, k1, z, 0, 0, 0);
    }
    float mx[4] = {-INFINITY, -INFINITY, -INFINITY, -INFINITY};
#pragma unroll
    for (int kb = 0; kb < 9; ++kb)
#pragma unroll
        for (int j = 0; j < 4; ++j) {
            const int rel = kb * 16 + l15 - (l4 * 4 + j);
            const int kabs = i0 - 128 + w16 + kb * 16 + l15;
            const bool ok = (rel >= 0) && (rel <= 128) && (kabs >= 0);
            const float v = ok ? s[kb][j] * 1.4426950408889634f : -INFINITY;
            s[kb][j] = v; mx[j] = fmaxf(mx[j], v);
        }
    float sm[4];
#pragma unroll
    for (int j = 0; j < 4; ++j) { mx[j] = grp_max16(mx[j]); sm[j] = 0.f; }
#pragma unroll
    for (int kb = 0; kb < 9; ++kb)
#pragma unroll
        for (int j = 0; j < 4; ++j) { const float p = __builtin_amdgcn_exp2f(s[kb][j] - mx[j]); sm[j] += p; Ps[(l4 * 4 + j) * 168 + kb * 16 + l15] = f2bf(p); }
#pragma unroll
    for (int j = 0; j < 4; ++j) sm[j] = grp_sum<16>(sm[j]);
    LDS_FENCE();
    f32x4 o[4];
#pragma unroll
    for (int db = 0; db < 4; ++db) o[db] = (f32x4){0.f, 0.f, 0.f, 0.f};
#pragma unroll
    for (int ks = 0; ks < 5; ++ks) {
        const bf16x8 pa = *(const bf16x8*)(Ps + l15 * 168 + ks * 32 + l4 * 8);
#pragma unroll
        for (int db = 0; db < 4; ++db) {
            const bf16x8 vb = *(const bf16x8*)(Vt + (db * 16 + l15) * 280 + w16 + ks * 32 + l4 * 8);
            o[db] = __builtin_amdgcn_mfma_f32_16x16x32_bf16(pa, vb, o[db], 0, 0, 0);
        }
    }
#pragma unroll
    for (int j = 0; j < 4; ++j) {
        const float inv = __builtin_amdgcn_rcpf(sm[j]);
        if (NOSTORE && !(sm[j] < 0.f)) continue;
        const size_t tq = rowbase + (size_t)(i0 + w16 + l4 * 4 + j) * dil + rho;
        bf16_t* op = ZT + tq * 2304 + qcol + l15;
#pragma unroll
        for (int db = 0; db < 4; ++db) op[db * 16] = f2bf(o[db][j] * inv);
        if (l15 == 0) LSE[tq * 12 + g * 4 + h] = (mx[j] + __builtin_amdgcn_logf(sm[j])) * 0.6931471805599453f;
    }
}
template <int PM  > DI void phase_D(const Ctx& C0) {
    Ctx C = C0;
    constexpr bool SCANS_ONLY = (PM == 1);
    volatile unsigned* lq = (volatile unsigned*)(C.lds + LDS_MISC);
    unsigned* ctr = (unsigned*)(C.ws + WS_CTL) + 64 * (1 + C.layer + (PM != 0 ? 2 : 0));
    constexpr int N_RW = 64, N_HG = 64, N_GLA = 32, N_AT = 4 * 3 * 4 * 32, N_MIX = N_RW + N_HG + N_GLA + (SCANS_ONLY ? 0 : N_AT);
    const int n_cw = CONV_REST + (C.layer == 0 ? CONV_WZ : 0), NTOT = N_MIX + (PM == 0 ? (n_cw + 7) / 8 : 0);
    for (;;) {
        __syncthreads();
        if (C.tid == 0) lq[0] = atomicAdd(ctr, 1u);
        __syncthreads();
        const int it = (int)lq[0];
        { unsigned char* w_ = C0.ws; KArg p_ = C0.p; asm volatile("" : "+s"(w_), "+s"(p_)); C.ws = w_; C.p = p_; }
        if (it >= NTOT) break;
        if (it < N_RW) scan_item<2>(C, it);
        else if (it < N_RW + N_HG) scan_item<0>(C, it - N_RW);
        else if (it < N_RW + N_HG + N_GLA) scan_item<1>(C, it - N_RW - N_HG);
        else if (it < N_MIX) attn_item<PM == 2>(C, it - N_RW - N_HG - N_GLA);
        else {
            const int wi = (it - N_MIX) * 8 + C.wave; float* scr = (float*)(C.lds + C.wave * 16384);
            const bool rest = wi < CONV_REST;
            if (wi < n_cw) conv_item(C, rest ? C.layer : 1, rest ? 1 : 0, rest ? wi : wi - CONV_REST, scr);
        }
    }
    __syncthreads();
}
DI void unpack4(u32x2 v, float* f) { f[0] = bflo(v.x); f[1] = bfhi(v.x); f[2] = bflo(v.y); f[3] = bfhi(v.y); }
DI u32x2 pack4(const float* f) { u32x2 v; v.x = pk2(f[0], f[1]); v.y = pk2(f[2], f[3]); return v; }
template <bool NOSTORE> DI void phase_E(const Ctx& C) {
    const int L = C.layer, lane = C.lane;
    bf16_t* OM = (bf16_t*)(C.ws + WS_OM);
    const bf16_t* ZA = (const bf16_t*)(C.ws + WS_ZA); const bf16_t* ZT = (const bf16_t*)(C.ws + WS_ZT);
    const bf16_t* VRW = (const bf16_t*)(C.ws + WS_VRW); const bf16_t* Sg = rw_slot(C, 0);
    const float* LSE = (const float*)(C.ws + WS_LSE); const float* BON = (const float*)(C.ws + WS_BONUS);
    const int c4 = lane * 4, h = lane >> 4;
    const f32x4 hgw = *(const f32x4*)(C.in(6) + L * 256 + c4), glw = *(const f32x4*)(C.in(9) + L * 256 + c4), lnw = *(const f32x4*)(C.in(19) + L * 256 + c4), lnb = *(const f32x4*)(C.in(20) + L * 256 + c4);
    const int gw = C.bid * 8 + C.wave, NGW = C.G * 8;
    for (int t = gw; t < T; t += NGW) {
        const size_t o = (size_t)t * 256 + c4;
        const u32x2 r0 = *(const u32x2*)(OM + o), r1 = *(const u32x2*)(OM + (size_t)T * 256 + o), r2 = *(const u32x2*)(OM + (size_t)2 * T * 256 + o);
        const u32x2 gh = *(const u32x2*)(ZA + (size_t)t * ZAW + 768 + c4), gg = *(const u32x2*)(ZA + (size_t)t * ZAW + 1536 + c4);
        const u32x2 vr = *(const u32x2*)(VRW + o), sg = *(const u32x2*)(Sg + o);
        const float bon = BON[t * 4 + h];
        const float l0 = LSE[t * 12 + h], l1 = LSE[t * 12 + 4 + h], l2 = LSE[t * 12 + 8 + h];
        const u32x2 a0 = *(const u32x2*)(ZT + (size_t)t * 2304 + c4), a1 = *(const u32x2*)(ZT + (size_t)t * 2304 + 256 + c4), a2 = *(const u32x2*)(ZT + (size_t)t * 2304 + 512 + c4);
        asm volatile("" ::: "memory");
        if (NOSTORE && !(l0 > 1e30f)) { if (bon > 1e30f && l1 > 1e30f && bflo(r0.x) + bflo(r1.x) + bflo(r2.x) + bflo(gh.x) + bflo(gg.x) + bflo(vr.x) + bflo(sg.x) + bflo(a0.x) + bflo(a1.x) + bflo(a2.x) + l2 > 1e30f) OM[o] = 0; continue; }
        float v[4], g[4], w[4], o4[4];
        {
            unpack4(r0, v); unpack4(gh, g);
            const float ms = grp_sum<16>((v[0] * v[0] + v[1] * v[1]) + (v[2] * v[2] + v[3] * v[3])) * (1.f / 64.f); const float rs = rsqrtf(ms + NEPS);
#pragma unroll
            for (int e = 0; e < 4; ++e) o4[e] = v[e] * rs * hgw[e] * sigmoidf_(g[e]);
            *(u32x2*)(OM + o) = pack4(o4);
        }
        {
            unpack4(r1, v); unpack4(gg, g);
            const float ms = grp_sum<16>((v[0] * v[0] + v[1] * v[1]) + (v[2] * v[2] + v[3] * v[3])) * (1.f / 64.f); const float rs = rsqrtf(ms + NEPS);
#pragma unroll
            for (int e = 0; e < 4; ++e) o4[e] = v[e] * rs * glw[e] * siluf_(g[e]);
            *(u32x2*)(OM + (size_t)T * 256 + o) = pack4(o4);
        }
        {
            unpack4(r2, v); unpack4(vr, w); unpack4(sg, g);
            const float mean = grp_sum<16>((v[0] + v[1]) + (v[2] + v[3])) * (1.f / 64.f);
            float d[4];
#pragma unroll
            for (int e = 0; e < 4; ++e) d[e] = v[e] - mean;
            const float var = grp_sum<16>((d[0] * d[0] + d[1] * d[1]) + (d[2] * d[2] + d[3] * d[3])) * (1.f / 64.f); const float rs = rsqrtf(var + 64e-5f);
#pragma unroll
            for (int e = 0; e < 4; ++e) o4[e] = (d[e] * rs * lnw[e] + lnb[e] + bon * w[e]) * g[e];
            *(u32x2*)(OM + (size_t)2 * T * 256 + o) = pack4(o4);
        }
        {
            const float m = fmaxf(l0, fmaxf(l1, l2));
            const float w0 = __expf(l0 - m), w1 = __expf(l1 - m), w2 = __expf(l2 - m), inv = __builtin_amdgcn_rcpf(w0 + w1 + w2);
            float x0[4], x1[4], x2[4]; unpack4(a0, x0); unpack4(a1, x1); unpack4(a2, x2);
#pragma unroll
            for (int e = 0; e < 4; ++e) o4[e] = (w0 * x0[e] + w1 * x1[e] + w2 * x2[e]) * inv;
            *(u32x2*)(OM + (size_t)3 * T * 256 + o) = pack4(o4);
        }
    }
    if (L > 0) rmsnorm_rows_bf16(C, C.p->out, C.in(1) + L * DM, (bf16_t*)(C.ws + WS_XN));
}
DI void phase_J(const Ctx& C) {
    const int L = C.layer;
    const bf16_t* U = (const bf16_t*)(C.ws + WS_U); bf16_t* Gb = (bf16_t*)(C.ws + WS_G);
    const float* cw = C.in(27) + (size_t)L * 3 * DFF; const float* cb = C.in(28) + (size_t)L * DFF;
    constexpr int NCG = DFF / 8, NRC = T / 32;
    for (int task = C.bid * 512 + C.tid; task < NCG * NRC; task += C.G * 512) {
        const int cgp = task % NCG, rc = task / NCG, f0 = cgp * 8, t0 = rc * 32;
        float w0[8], w1[8], w2[8], bb[8], u1[8], u2[8];
#pragma unroll
        for (int e = 0; e < 8; e += 4) { *(f32x4*)(w0 + e) = *(const f32x4*)(cw + f0 + e); *(f32x4*)(w1 + e) = *(const f32x4*)(cw + DFF + f0 + e); *(f32x4*)(w2 + e) = *(const f32x4*)(cw + 2 * DFF + f0 + e); *(f32x4*)(bb + e) = *(const f32x4*)(cb + f0 + e); }
        if ((t0 & (SEQ - 1)) != 0) { unpack8(*(const u32x4*)(U + (size_t)(t0 - 1) * DFF + f0), u1); unpack8(*(const u32x4*)(U + (size_t)(t0 - 2) * DFF + f0), u2); }
        else {
#pragma unroll
            for (int e = 0; e < 8; ++e) { u1[e] = 0.f; u2[e] = 0.f; }
        }
        for (int tb = t0; tb < t0 + 32; tb += 8) {
            u32x4 uw[8], gw8[8];
#pragma unroll
            for (int i = 0; i < 8; ++i) { uw[i] = *(const u32x4*)(U + (size_t)(tb + i) * DFF + f0); gw8[i] = *(const u32x4*)(Gb + (size_t)(tb + i) * DFF + f0); }
            asm volatile("" ::: "memory");
#pragma unroll
            for (int i = 0; i < 8; ++i) {
                float u0[8], g[8], a[8];
                unpack8(uw[i], u0); unpack8(gw8[i], g);
#pragma unroll
                for (int e = 0; e < 8; ++e) { const float v = bb[e] + w0[e] * u0[e] + w1[e] * u1[e] + w2[e] * u2[e]; a[e] = siluf_(v) * g[e]; u2[e] = u1[e]; u1[e] = u0[e]; }
                *(u32x4*)(Gb + (size_t)(tb + i) * DFF + f0) = pack8(a);
            }
        }
    }
}
DI void final_norm(const Ctx& C) {
    float* xo = C.p->out; const float* w = C.in(3);
    const int gw = C.bid * 8 + C.wave, NGW = C.G * 8;
    f32x4 wv[4];
#pragma unroll
    for (int j = 0; j < 4; ++j) wv[j] = *(const f32x4*)(w + 4 * C.lane + 256 * j);
    for (int m = gw; m < T; m += NGW) {
        float* xr = xo + (size_t)m * DM + 4 * C.lane; f32x4 v[4]; float s = 0.f;
#pragma unroll
        for (int j = 0; j < 4; ++j) { v[j] = *(const f32x4*)(xr + 256 * j); s += (v[j][0] * v[j][0] + v[j][1] * v[j][1]) + (v[j][2] * v[j][2] + v[j][3] * v[j][3]); }
        const float rstd = rsqrtf(wave_sum(s) * (1.f / DM) + NEPS);
#pragma unroll
        for (int j = 0; j < 4; ++j) *(f32x4*)(xr + 256 * j) = v[j] * rstd * wv[j];
    }
}

#define LAS __attribute__((address_space(3)))
constexpr int CW_BAR = 4096;
#define XB_TMO      128
#define XB_XCNT(j)  (256  + 64 * (j))
#define XB_XSUB(j)  (1280 + 64 * (j))
#define XB_XGEN(j)  (2304 + 64 * (j))
#define XB_TOP      3328
#define XB_TOPGEN   3392
#define XCD_BAR_WORDS 3456
#define XB_SPIN_CAP (1u << 18)

__device__ __forceinline__ unsigned xb_ld(unsigned* p)              { return __hip_atomic_load(p, __ATOMIC_RELAXED, __HIP_MEMORY_SCOPE_AGENT); }
__device__ __forceinline__ unsigned xb_add(unsigned* p, unsigned v) { return __hip_atomic_fetch_add(p, v, __ATOMIC_RELAXED, __HIP_MEMORY_SCOPE_AGENT); }
__device__ __forceinline__ unsigned xb_xcc_id() { return (unsigned)__builtin_amdgcn_s_getreg((3 << 11) | 20) & 0xFu; }
#define XB_SPIN(cond, bar) do { unsigned _sp = 0; while (cond) { __builtin_amdgcn_s_sleep(1); \
    if ((++_sp & 255u) == 0u) { if (xb_ld(&(bar)[XB_TMO])) break; if (_sp > XB_SPIN_CAP) { atomicAdd(&(bar)[XB_TMO], 1u); break; } } } } while (0)

struct XcdBarrier {
    unsigned* bar; unsigned x;
    volatile LAS unsigned* st;
};

__device__ __forceinline__ XcdBarrier xcd_barrier_post(unsigned* bar, volatile LAS unsigned* st) {
    XcdBarrier b; b.bar = bar; b.x = xb_xcc_id(); b.st = st;
    if (threadIdx.x == 0) (void)xb_add(&bar[XB_XCNT(b.x)], 1u);
    return b;
}
__device__ __forceinline__ void xcd_barrier_complete(unsigned* bar, unsigned x, unsigned& nloc, unsigned& nx) {
    const unsigned G = gridDim.x * gridDim.y * gridDim.z;
    unsigned sum, cnt, mine, sp = 0u;
    for (;;) {
        sum = 0u; cnt = 0u; mine = 0u;
#pragma unroll
        for (unsigned j = 0; j < 16; ++j) { const unsigned c = xb_ld(&bar[XB_XCNT(j)]); sum += c; cnt += (c > 0u) ? 1u : 0u; mine = (j == x) ? c : mine; }
        if (sum == G) break;
        __builtin_amdgcn_s_sleep(1);
        if ((++sp & 255u) == 0u) { if (xb_ld(&bar[XB_TMO])) break; if (sp > XB_SPIN_CAP) { atomicAdd(&bar[XB_TMO], 1u); break; } }
    }
    nloc = mine > 0u ? mine : 1u; nx = cnt > 0u ? cnt : 1u;
}

__device__ __forceinline__ void xcd_barrier(const XcdBarrier& b, const bool is_t0) {
    asm volatile("s_waitcnt vmcnt(0)" ::: "memory");
    __syncthreads();
    if (is_t0) {
        unsigned* bar = b.bar;
        __builtin_amdgcn_s_waitcnt(0);
        unsigned nloc = b.st[0], nx = b.st[1];
        if (nloc == 0u) { xcd_barrier_complete(bar, b.x, nloc, nx); b.st[0] = nloc; b.st[1] = nx; }
        const unsigned old = xb_add(&bar[XB_XSUB(b.x)], 1u);
        const unsigned gen = old / nloc;
        if (old + 1u == (gen + 1u) * nloc) {
            __builtin_amdgcn_fence(__ATOMIC_RELEASE, "agent");
            asm volatile("s_waitcnt vmcnt(0)" ::: "memory");
            const unsigned og = xb_add(&bar[XB_TOP], 1u);
            const unsigned tg = og / nx;
            if (og + 1u == (tg + 1u) * nx) xb_add(&bar[XB_TOPGEN], 1u);
            else XB_SPIN(xb_ld(&bar[XB_TOPGEN]) == tg, bar);
            __builtin_amdgcn_fence(__ATOMIC_ACQUIRE, "agent");
            xb_add(&bar[XB_XGEN(b.x)], 1u);
            asm volatile("s_waitcnt vmcnt(0)" ::: "memory");
        } else {
            XB_SPIN(xb_ld(&bar[XB_XGEN(b.x)]) == gen, bar);
            __builtin_amdgcn_fence(__ATOMIC_ACQUIRE, "agent");
            asm volatile("s_waitcnt vmcnt(0)" ::: "memory");
        }
    }
    __syncthreads();
}

#ifndef DUP
#define DUP 0
#endif
#ifndef PHM
#define PHM 2047
#endif
DI Ctx mkctx_(int L, unsigned char* lds, int wave0) {
    KArg ka = (KArg)__builtin_amdgcn_kernarg_segment_ptr(); int tv = wave0 * 64 + lane_id_(), lv = L, gv = gridDim.x, bv = blockIdx.x;
    asm volatile("" : "+s"(ka), "+v"(tv), "+s"(lv), "+s"(gv), "+s"(bv));
    Ctx C; C.p = ka; C.tid = tv; C.lane = tv & 63; C.wave = wave0; C.G = gv; C.bid = bv; C.ws = ka->ws; C.lds = lds; C.layer = lv;
    return C;
}
DI void grid_bar_(unsigned char* lds, int wave0) {
    KArg ka = (KArg)__builtin_amdgcn_kernarg_segment_ptr(); asm volatile("" : "+s"(ka));
    XcdBarrier b; b.bar = (unsigned*)(ka->ws + WS_CTL) + CW_BAR; b.x = xb_xcc_id(); b.st = (volatile LAS unsigned*)(LAS unsigned char*)(lds + LDS_MISC + 32);
    xcd_barrier(b, wave0 == 0 && lane_id_() == 0);
#if DUP & 1024
    xcd_barrier(b, wave0 == 0 && lane_id_() == 0);
#endif
}
template <int L> DI void run_layer(cg::grid_group& grid, unsigned char* lds, int wave0) {
    PG8_LAS unsigned char* ldsl = (PG8_LAS unsigned char*)lds;
#if PHM & 1
        { const Ctx C = mkctx_(L, lds, wave0); phase_A(C); }
#if DUP & 2
        { const Ctx C = mkctx_(L, lds, wave0); phase_A(C); }
#endif
#endif
        grid_bar_(lds, wave0);
        if (L == 0 && gridDim.x == 0x7fffffffu) grid.sync();
#if PHM & 2
        {
            const Ctx C = mkctx_(L, lds, wave0); const bf16_t* XN = (L == 0) ? (const bf16_t*)C.p->out : (const bf16_t*)(C.ws + WS_XN);
            pg8::Gemm g{XN, (const bf16_t*)(C.ws + WS_WZ), T, NZ, 1024}; pg8::StaticOrder S; S.init(T, NZ, C.G, C.bid);
            EpiZ E{(bf16_t*)(C.ws + WS_ZA), (bf16_t*)(C.ws + WS_OM), (bf16_t*)(C.ws + WS_ZT), (const float*)(C.ws + WS_ROPEC), (const float*)(C.ws + WS_ROPES)};
            pg8::gemm_phase<EpiZ, pg8::StaticOrder, true, true>(ldsl, g, S, E, C.wave);
#if DUP & 1
            pg8::gemm_phase<EpiZ, pg8::StaticOrder, true, true>(ldsl, g, S, E, C.wave);
#endif
        }
#endif
        grid_bar_(lds, wave0);
#if PHM & 4
        { const Ctx C = mkctx_(L, lds, wave0); phase_C(C); }
#if DUP & 2
        if (L == 0) { const Ctx C = mkctx_(L, lds, wave0); phase_C(C); }
#endif
#endif
        grid_bar_(lds, wave0);
#if PHM & 8
#if DUP & 4
        { const Ctx C = mkctx_(L, lds, wave0); phase_D<1>(C); }
#endif
#if DUP & 8
        { const Ctx C = mkctx_(L, lds, wave0); phase_D<2>(C); }
#endif
        { const Ctx C = mkctx_(L, lds, wave0); phase_D<0>(C); }
#endif
        grid_bar_(lds, wave0);
#if PHM & 16
#if DUP & 2048
        { const Ctx C = mkctx_(L, lds, wave0); phase_E<true>(C); }
#endif
        { const Ctx C = mkctx_(L, lds, wave0); phase_E<false>(C); }
#endif
        grid_bar_(lds, wave0);
#if PHM & 64
        {
            const Ctx C = mkctx_(L, lds, wave0);
            pg8::Gemm g{(const bf16_t*)(C.ws + WS_OM), (const bf16_t*)(C.ws + WS_WB), 4 * T, 4096, 256}; ProjOrder S{C.G, C.bid};
            EpiSplit<0> E{(bf16_t*)(C.ws + WS_PROJ), 1024, 4, 0};
            pg8::gemm_phase<EpiSplit<0>, ProjOrder, true, true>(ldsl, g, S, E, C.wave);
        }
#endif
        __syncthreads();
#if PHM & 32
        {
            const Ctx C = mkctx_(L, lds, wave0); const bf16_t* XN = (L == 0) ? (const bf16_t*)C.p->out : (const bf16_t*)(C.ws + WS_XN);
            pg8::Gemm g{XN, (const bf16_t*)(C.ws + WS_WG), T, 4096, 1024}; GateOrder S{C.G, C.bid};
            EpiGateMerge E{(const bf16_t*)(C.ws + WS_PROJ), (bf16_t*)(C.ws + WS_MERGED)};
            pg8::gemm_phase<EpiGateMerge, GateOrder, true, true>(ldsl, g, S, E, C.wave);
        }
#endif
        grid_bar_(lds, wave0);
#if PHM & 128
        {
            const Ctx C = mkctx_(L, lds, wave0);
            pg8::Gemm g{(const bf16_t*)(C.ws + WS_MERGED), (const bf16_t*)(C.ws + WS_WO), T, 1024, 1024}; pg8::StaticOrder S; S.init(T, 1024, C.G, C.bid);
            EpiRes<true> E{(C.layer == 0) ? C.p->in[0] : (const float*)C.p->out, C.p->out, (bf16_t*)(C.ws + WS_XN2), (float*)(C.ws + WS_SSQ)};
            pg8::gemm_phase<EpiRes<true>, pg8::StaticOrder, true, true>(ldsl, g, S, E, C.wave);
        }
#endif
        grid_bar_(lds, wave0);
#if PHM & 256
        {
            const Ctx C = mkctx_(L, lds, wave0);
            pg8::Gemm g{(const bf16_t*)(C.ws + WS_XN2), (const bf16_t*)(C.ws + WS_WUP), T, 2 * DFF, 1024}; pg8::StaticOrder S; S.init(T, 2 * DFF, C.G, C.bid);
            EpiUpAct E{(bf16_t*)(C.ws + WS_ACT), (const float*)(C.ws + WS_SSQ), C.in(27) + (size_t)C.layer * 3 * DFF, C.in(28) + (size_t)C.layer * DFF, (float*)(C.ws + WS_EDGE), (PG8_LAS float*)(ldsl + LDS_MISC + 1024)};
            pg8::gemm_phase<EpiUpAct, pg8::StaticOrder, true, true>(ldsl, g, S, E, C.wave);
        }
#endif
        grid_bar_(lds, wave0);
#if PHM & 1024
        {
            const Ctx C = mkctx_(L, lds, wave0);
            pg8::Gemm g{(const bf16_t*)(C.ws + WS_ACT), (const bf16_t*)(C.ws + WS_WDN), T, 1024, DFF}; pg8::StaticOrder S; S.init(T, 1024, C.G, C.bid);
            { pg8::Unit uu; for (int i = 0; S.next(i, uu); ++i) ffn_edge_fixup(C, uu.pm); }
            asm volatile("s_waitcnt vmcnt(0)" ::: "memory"); __syncthreads();
            EpiRes<false> E{C.p->out, C.p->out, nullptr, nullptr};
            pg8::gemm_phase<EpiRes<false>, pg8::StaticOrder, true, true>(ldsl, g, S, E, C.wave);
        }
#endif
        grid_bar_(lds, wave0);
    }
__global__ void __launch_bounds__(512, 2) fwd_megakernel(Params prm) {
    extern __shared__ __attribute__((aligned(16))) unsigned char lds[];
    cg::grid_group grid = cg::this_grid();
    const int wave0 = __builtin_amdgcn_readfirstlane(threadIdx.x >> 6);
    if (threadIdx.x < 16) ((volatile LAS unsigned*)(LAS unsigned char*)(lds + LDS_MISC))[threadIdx.x] = 0u;
    __syncthreads();
    (void)xcd_barrier_post((unsigned*)(prm.ws + WS_CTL) + CW_BAR, (volatile LAS unsigned*)(LAS unsigned char*)(lds + LDS_MISC + 32));
    run_layer<0>(grid, lds, wave0);
    run_layer<1>(grid, lds, wave0);
    { const Ctx C = mkctx_(0, lds, wave0); final_norm(C); }
}

extern "C" void kernel_launch(void* const* d_in, const int* in_sizes, int n_in, void* d_out, int out_size, void* d_ws, size_t ws_size, hipStream_t stream) {
    static int grid = 0;
    if (grid == 0) {
        if (n_in != 30 || out_size != T * DM || ws_size < WS_END) { fprintf(stderr, "kernel_launch: unexpected problem (n_in %d out %d ws %zu)\n", n_in, out_size, ws_size); grid = -1; return; }
        int dev = 0, cus = 0, per_cu = 0;
        (void)hipGetDevice(&dev); (void)hipDeviceGetAttribute(&cus, hipDeviceAttributeMultiprocessorCount, dev);
        (void)hipFuncSetAttribute((const void*)fwd_megakernel, hipFuncAttributeMaxDynamicSharedMemorySize, LDS_BYTES);
        (void)hipOccupancyMaxActiveBlocksPerMultiprocessor(&per_cu, (const void*)fwd_megakernel, 512, LDS_BYTES);
        if (per_cu < 1) { fprintf(stderr, "kernel_launch: occupancy query says %d\n", per_cu); per_cu = 1; }
        (void)hipGetLastError();
        grid = cus * 1;
    }
    if (grid < 0) return;
    (void)hipMemsetAsync((char*)d_ws + WS_CTL, 0, 65536, stream);
    Params p{};
    for (int i = 0; i < 30; ++i) p.in[i] = (const float*)d_in[i];
    p.out = (float*)d_out; p.ws = (unsigned char*)d_ws;
    void* args[] = {&p};
    hipError_t e = hipLaunchCooperativeKernel((const void*)fwd_megakernel, dim3(grid), dim3(512), args, LDS_BYTES, stream);
    if (e != hipSuccess) fprintf(stderr, "cooperative launch failed: %s (grid %d)\n", hipGetErrorString(e), grid);
}
```

```cpp
#include <hip/hip_runtime.h>
#include <hip/hip_cooperative_groups.h>
#include <cstdio>
#include <cstdint>
namespace cg = cooperative_groups;
#define DI __device__ __forceinline__
DI int lane_id_() { int l; asm volatile("v_mbcnt_lo_u32_b32 %0, -1, 0\n\tv_mbcnt_hi_u32_b32 %0, -1, %0" : "=v"(l)); return l; }
namespace pg8 {
#define PG8_LAS __attribute__((address_space(3)))
typedef unsigned short bf16_t;
typedef short bf16x8 __attribute__((ext_vector_type(8)));
typedef float f32x4 __attribute__((ext_vector_type(4)));
typedef unsigned u32x4 __attribute__((ext_vector_type(4)));
constexpr int BM = 256, BK = 64, HALF = 128, HTB = HALF * BK * 2  , STAGE_BYTES = 8 * HTB, NXCD = 8, WGM = 8;

__host__ __device__ __forceinline__ int lds_byte(int r, int c) { const int st = (r >> 4) * 2 + (c >> 5), rr = r & 15, cc = c & 31, ob = rr * 64 + cc * 2; return st * 1024 + (ob ^ (((ob >> 9) & 1) << 5)); }
__host__ __device__ __forceinline__ void stage_rc(int b, int& R, int& C) { const int st = b / 1024, sb = b % 1024, swz = sb ^ (((sb >> 9) & 1) << 5); R = (st >> 1) * 16 + swz / 64; C = (st & 1) * 32 + (swz % 64) / 2; }
__host__ __device__ __forceinline__ int perm32(int rho) { const int n = rho >> 4, i = rho & 15; return 8 * (i >> 2) + 4 * n + (i & 3); }

struct Unit { int pm, pn; };
struct Gemm { const bf16_t* A; const bf16_t* Bt; int M, N, K; };

struct StaticOrder {
    int nM, nN, nwg, G, c;
    __host__ __device__ void init(int M, int N, int G_, int c_) { nM = M / BM; nN = N / BM; nwg = nM * nN; G = G_; c = c_; }
    __host__ __device__ bool next(int i, Unit& u) const {
        const long L = (long)i * G + c; if (L >= nwg) return false;
        int wgid = (int)L; { const int q = nwg / NXCD, r = nwg % NXCD, xcd = wgid % NXCD, off = wgid / NXCD; wgid = (xcd < r ? xcd * (q + 1) : r * (q + 1) + (xcd - r) * q) + off; }
        const int nig = WGM * nN, gid = wgid / nig, fm = gid * WGM, gsz = (nM - fm) < WGM ? (nM - fm) : WGM;
        u.pm = fm + ((wgid % nig) % gsz); u.pn = (wgid % nig) / gsz; return true;
    }
    __device__ __forceinline__ void a_ready(const Unit&) const {}
    __device__ __forceinline__ void done(const Unit&) const {}
};
__device__ __forceinline__ unsigned cvt_pk_bf16(float lo, float hi) { unsigned r; asm volatile("v_cvt_pk_bf16_f32 %0, %1, %2" : "=v"(r) : "v"(lo), "v"(hi)); return r; }
typedef float f32x2 __attribute__((ext_vector_type(2)));
template <class Epi, class Sched, bool ALIGN_EPI = false, bool SP2 = false>
__device__ __forceinline__ void gemm_phase(PG8_LAS unsigned char* lds, const Gemm g, const Sched& S, const Epi& E, int wave0) {
    int tid_ = wave0 * 64 + lane_id_();
    const int tid = tid_, wid = __builtin_amdgcn_readfirstlane(tid >> 6), lane = tid & 63, wr = wid >> 2, wc = wid & 3, fr = lane & 15, fq = lane >> 4;
    const int K = g.K, nt = K / BK;
    unsigned voffA[2], voffB[2];
#pragma unroll
    for (int i = 0; i < 2; ++i) { int R, C; stage_rc(tid * 16 + i * 8192, R, C); const int Rb = Epi::PERM ? ((R & ~31) + perm32(R & 31)) : R;
        voffA[i] = (unsigned)(R * K + C) * 2u; voffB[i] = (unsigned)(Rb * K + C) * 2u; }
    const size_t kstep = (size_t)(BK * 2);
    const size_t hstep = (size_t)HALF * K * 2;
    const size_t tstep = 2 * hstep;
    const unsigned ldsw = (unsigned)wid * 1024u;
    const int aoff = lds_byte(wr * 64 + fr, fq * 8), boff = lds_byte(wc * 32 + fr, fq * 8);
#define PG8_SA(b, h) (((b) * 2 + (h)) * HTB)
#define PG8_SB(b, h) ((4 + (b) * 2 + (h)) * HTB)
#define PG8_STAGE(bufoff, gbase, voff) do { _Pragma("unroll") for (int _i = 0; _i < 2; ++_i) \
        __builtin_amdgcn_global_load_lds((const unsigned*)((const char*)(gbase) + (voff)[_i]), (PG8_LAS unsigned*)(lds + (bufoff) + ldsw + _i * 8192), 16, 0, 0); } while (0)
#define PG8_LDA(dst, b, h) do { _Pragma("unroll") for (int m = 0; m < 4; ++m) _Pragma("unroll") for (int k = 0; k < 2; ++k) dst[m][k] = *(const PG8_LAS bf16x8*)(lds + PG8_SA(b, h) + aoff + m * 2048 + k * 1024); } while (0)
#define PG8_LDB(dst, b, h) do { _Pragma("unroll") for (int n = 0; n < 2; ++n) _Pragma("unroll") for (int k = 0; k < 2; ++k) dst[n][k] = *(const PG8_LAS bf16x8*)(lds + PG8_SB(b, h) + boff + n * 2048 + k * 1024); } while (0)
#define PG8_MMA(ai, bj, At, Bt) do { __builtin_amdgcn_s_setprio(1); _Pragma("unroll") for (int m = 0; m < 4; ++m) _Pragma("unroll") for (int n = 0; n < 2; ++n) _Pragma("unroll") for (int k = 0; k < 2; ++k) \
        acc[ai][bj][m][n] = __builtin_amdgcn_mfma_f32_16x16x32_bf16(Bt[n][k], At[m][k], acc[ai][bj][m][n], 0, 0, 0); __builtin_amdgcn_s_setprio(0); } while (0)
#define PG8_WAIT_V(n) asm volatile("s_waitcnt vmcnt(" #n ")" ::: "memory")
#define PG8_WAIT_L(n) asm volatile("s_waitcnt lgkmcnt(" #n ")" ::: "memory")
#define PG8_BAR __builtin_amdgcn_s_barrier()
#define PG8_SCHED __builtin_amdgcn_sched_barrier(0)
    Unit cur, nxt; int ui = 0;
    if (!S.next(0, cur)) return;
    f32x4 acc[2][2][4][2];
#pragma unroll
    for (int a = 0; a < 2; ++a)
#pragma unroll
        for (int b = 0; b < 2; ++b)
#pragma unroll
            for (int m = 0; m < 4; ++m)
#pragma unroll
                for (int n = 0; n < 2; ++n) acc[a][b][m][n] = (f32x4){0.f, 0.f, 0.f, 0.f};
    bf16x8 At[4][2], B0[2][2], B1[2][2];
    const char* cA = (const char*)g.A + (size_t)cur.pm * tstep; const char* cB = (const char*)g.Bt + (size_t)cur.pn * tstep;
    S.a_ready(cur);
    if constexpr (SP2) {
        PG8_STAGE(PG8_SB(0, 0), cB, voffB); PG8_STAGE(PG8_SB(0, 1), cB + hstep, voffB); PG8_STAGE(PG8_SA(0, 0), cA, voffA); PG8_STAGE(PG8_SA(0, 1), cA + hstep, voffA);
        if (wr == 1) PG8_BAR;
        PG8_WAIT_V(2); PG8_BAR;
        PG8_STAGE(PG8_SB(1, 0), cB + kstep, voffB); PG8_STAGE(PG8_SA(1, 0), cA + kstep, voffA); PG8_STAGE(PG8_SB(1, 1), cB + hstep + kstep, voffB);
        PG8_WAIT_V(6); PG8_BAR;
    } else {
        PG8_STAGE(PG8_SB(0, 0), cB, voffB); PG8_STAGE(PG8_SA(0, 0), cA, voffA); PG8_STAGE(PG8_SB(0, 1), cB + hstep, voffB); PG8_STAGE(PG8_SA(0, 1), cA + hstep, voffA);
        if (wr == 1) PG8_BAR;
        PG8_WAIT_V(4); PG8_BAR;
        PG8_STAGE(PG8_SB(1, 0), cB + kstep, voffB); PG8_STAGE(PG8_SA(1, 0), cA + kstep, voffA); PG8_STAGE(PG8_SB(1, 1), cB + hstep + kstep, voffB);
        PG8_WAIT_V(6); PG8_BAR;
    }
    for (;;) {
        const bool has_next = S.next(ui + 1, nxt);
        const char* nA = has_next ? (const char*)g.A + (size_t)nxt.pm * tstep : cA; const char* nB = has_next ? (const char*)g.Bt + (size_t)nxt.pn * tstep : cB;
        for (int t = 0; t < nt; t += 2) {
            const bool last = (t == nt - 2);
            const char* a1 = cA + (size_t)(t + 1) * kstep;
            const char* a2 = last ? nA : cA + (size_t)(t + 2) * kstep; const char* b2 = last ? nB : cB + (size_t)(t + 2) * kstep;
            const char* a3 = a2 + kstep; const char* b3 = b2 + kstep;
            if (last && has_next) S.a_ready(nxt);
            if constexpr (SP2) {
            PG8_LDB(B0, 0, 0); PG8_LDB(B1, 0, 1); PG8_SCHED; PG8_LDA(At, 0, 0); PG8_STAGE(PG8_SA(1, 1), a1 + hstep, voffA);
            PG8_WAIT_V(8); PG8_WAIT_L(0); PG8_BAR; PG8_MMA(0, 0, At, B0); PG8_MMA(0, 1, At, B1); PG8_BAR; PG8_SCHED;
            PG8_LDA(At, 0, 1); PG8_STAGE(PG8_SB(0, 0), b2, voffB); PG8_STAGE(PG8_SB(0, 1), b2 + hstep, voffB); PG8_STAGE(PG8_SA(0, 0), a2, voffA);
            PG8_WAIT_V(8); PG8_WAIT_L(0); PG8_BAR; PG8_MMA(1, 0, At, B0); PG8_MMA(1, 1, At, B1); PG8_BAR; PG8_SCHED;
            PG8_LDB(B0, 1, 0); PG8_LDB(B1, 1, 1); PG8_SCHED; PG8_LDA(At, 1, 0); PG8_STAGE(PG8_SA(0, 1), a2 + hstep, voffA);
            PG8_WAIT_V(8); PG8_WAIT_L(0); PG8_BAR; PG8_MMA(0, 0, At, B0); PG8_MMA(0, 1, At, B1); PG8_BAR; PG8_SCHED;
            PG8_LDA(At, 1, 1); PG8_STAGE(PG8_SB(1, 0), b3, voffB); PG8_STAGE(PG8_SB(1, 1), b3 + hstep, voffB); PG8_STAGE(PG8_SA(1, 0), a3, voffA);
            PG8_WAIT_V(8); PG8_WAIT_L(0); PG8_BAR; PG8_MMA(1, 0, At, B0); PG8_MMA(1, 1, At, B1); PG8_BAR; PG8_SCHED;
            } else {
            PG8_LDB(B0, 0, 0); PG8_SCHED; PG8_LDA(At, 0, 0); PG8_STAGE(PG8_SA(1, 1), a1 + hstep, voffA);
            PG8_WAIT_L(8); PG8_BAR; PG8_WAIT_L(0); PG8_MMA(0, 0, At, B0); PG8_BAR; PG8_SCHED;
            PG8_LDB(B1, 0, 1); PG8_STAGE(PG8_SB(0, 0), b2, voffB);
            PG8_BAR; PG8_WAIT_L(0); PG8_MMA(0, 1, At, B1); PG8_BAR;
            PG8_LDA(At, 0, 1); PG8_STAGE(PG8_SA(0, 0), a2, voffA);
            PG8_BAR; PG8_WAIT_L(0); PG8_MMA(1, 0, At, B0); PG8_BAR; PG8_SCHED;
            PG8_STAGE(PG8_SB(0, 1), b2 + hstep, voffB);
            PG8_WAIT_V(6); PG8_BAR; PG8_MMA(1, 1, At, B1); PG8_BAR;
            PG8_LDB(B0, 1, 0); PG8_SCHED; PG8_LDA(At, 1, 0); PG8_STAGE(PG8_SA(0, 1), a2 + hstep, voffA);
            PG8_WAIT_L(8); PG8_BAR; PG8_WAIT_L(0); PG8_MMA(0, 0, At, B0); PG8_BAR; PG8_SCHED;
            PG8_LDB(B1, 1, 1); PG8_STAGE(PG8_SB(1, 0), b3, voffB);
            PG8_BAR; PG8_WAIT_L(0); PG8_MMA(0, 1, At, B1); PG8_BAR;
            PG8_LDA(At, 1, 1); PG8_STAGE(PG8_SA(1, 0), a3, voffA);
            PG8_BAR; PG8_WAIT_L(0); PG8_MMA(1, 0, At, B0); PG8_BAR; PG8_SCHED;
            PG8_STAGE(PG8_SB(1, 1), b3 + hstep, voffB);
            PG8_WAIT_V(6); PG8_BAR; PG8_MMA(1, 1, At, B1); PG8_BAR;
            }
        }
        if constexpr (ALIGN_EPI) { if (wr == 0) PG8_BAR; }
        if constexpr (!Epi::AFTER_DRAIN) { E(acc, cur, wr, wc, fr, fq); S.done(cur); }
        if (!has_next) break;
#pragma unroll
        for (int a = 0; a < 2; ++a)
#pragma unroll
            for (int b = 0; b < 2; ++b)
#pragma unroll
                for (int m = 0; m < 4; ++m)
#pragma unroll
                    for (int n = 0; n < 2; ++n) acc[a][b][m][n] = (f32x4){0.f, 0.f, 0.f, 0.f};
        cur = nxt; cA = nA; cB = nB; ++ui;
        if constexpr (ALIGN_EPI) { if (wr == 1) PG8_BAR; }
    }
    PG8_WAIT_V(0);
    if constexpr (!ALIGN_EPI) { if (wr == 0) PG8_BAR; }
    PG8_BAR;
    if constexpr (Epi::AFTER_DRAIN) { E.fused(acc, cur, wr, wc, fr, fq, lds, wid, lane); S.done(cur); }
#undef PG8_SA
#undef PG8_SB
#undef PG8_STAGE
#undef PG8_LDA
#undef PG8_LDB
#undef PG8_MMA
#undef PG8_WAIT_V
#undef PG8_WAIT_L
#undef PG8_BAR
#undef PG8_SCHED
}
}

typedef unsigned short bf16_t;
typedef float f32x4 __attribute__((ext_vector_type(4)));
typedef short bf16x8 __attribute__((ext_vector_type(8)));
typedef unsigned u32x4 __attribute__((ext_vector_type(4)));
typedef unsigned u32x2 __attribute__((ext_vector_type(2)));

constexpr int T = 16384, SEQ = 4096, DM = 1024, NIN = 9104, DFF = 2816;
constexpr int NZ = 5120;
constexpr int ZAW = 1792;
constexpr float NEPS = 1e-6f;
constexpr size_t MiB = 1u << 20;
constexpr size_t WS_CTL = 0;
constexpr size_t WS_ROPEC = 1 * MiB, WS_ROPES = WS_ROPEC + 512 * 1024;
constexpr size_t WS_LSE = 2 * MiB, WS_BONUS = WS_LSE + 768 * 1024;
constexpr size_t WS_WZ = 3 * MiB, WS_WG = WS_WZ + (size_t)NZ * 1024 * 2, WS_WB = WS_WG + 8 * MiB, WS_WO = WS_WB + 2 * MiB, WS_WUP = WS_WO + 2 * MiB, WS_WDN = WS_WUP + 11 * MiB;
static_assert(WS_WDN + (size_t)1024 * 2816 * 2 <= 42 * MiB, "weight region");
constexpr size_t WS_VRW = 42 * MiB;
constexpr size_t WS_OM = 50 * MiB;
constexpr size_t WS_ZA = 82 * MiB;
constexpr size_t WS_ZT = 146 * MiB;
constexpr size_t WS_RW = 218 * MiB;
constexpr size_t SLOT = 8 * MiB;
constexpr size_t WS_XN = 242 * MiB;
constexpr size_t WS_PROJ = 82 * MiB;
constexpr size_t WS_MERGED = 210 * MiB;
constexpr size_t WS_XN2 = 242 * MiB;
constexpr size_t WS_U = 50 * MiB, WS_G = 138 * MiB;
constexpr size_t WS_ACT = 138 * MiB;
constexpr size_t WS_EDGE = 50 * MiB;
constexpr size_t WS_SSQ = 274 * MiB;
constexpr size_t WS_END = 275 * MiB;

constexpr int LDS_BYTES = 147456, LDS_MISC = 131072;

DI float bf2f(unsigned v) { return __uint_as_float(v << 16); }
DI float bflo(unsigned w) { return __uint_as_float(w << 16); }
DI float bfhi(unsigned w) { return __uint_as_float(w & 0xffff0000u); }
DI unsigned pk2(float lo, float hi) { return pg8::cvt_pk_bf16(lo, hi); }
DI bf16_t f2bf(float f) { return (bf16_t)(pk2(f, 0.f) & 0xffffu); }
DI float sigmoidf_(float x) { return __builtin_amdgcn_rcpf(1.f + __expf(-x)); }
DI float siluf_(float x) { return x * __builtin_amdgcn_rcpf(1.f + __expf(-x)); }
DI void unpack8(u32x4 v, float* f) { f[0] = bflo(v.x); f[1] = bfhi(v.x); f[2] = bflo(v.y); f[3] = bfhi(v.y); f[4] = bflo(v.z); f[5] = bfhi(v.z); f[6] = bflo(v.w); f[7] = bfhi(v.w); }
DI u32x4 pack8(const float* f) { u32x4 v; v.x = pk2(f[0], f[1]); v.y = pk2(f[2], f[3]); v.z = pk2(f[4], f[5]); v.w = pk2(f[6], f[7]); return v; }
template <int CTRL> DI float dpp_mov(float x);
DI float wave_sum(float v);
template <int CTRL> DI float dpp_mov(float x) { return __int_as_float(__builtin_amdgcn_update_dpp(0, __float_as_int(x), CTRL, 0xf, 0xf, true)); }
template <int NL> DI float grp_sum(float x) {
    x += dpp_mov<0xB1>(x); x += dpp_mov<0x4E>(x); x += dpp_mov<0x141>(x); if (NL == 16) x += dpp_mov<0x140>(x); return x;
}
DI float wave_sum(float v) {
    v += dpp_mov<0xB1>(v); v += dpp_mov<0x4E>(v); v += dpp_mov<0x141>(v); v += dpp_mov<0x140>(v);
    const int iv = __float_as_int(v);
    const float a = __int_as_float(__builtin_amdgcn_readlane(iv, 0)), b = __int_as_float(__builtin_amdgcn_readlane(iv, 16));
    const float c = __int_as_float(__builtin_amdgcn_readlane(iv, 32)), d = __int_as_float(__builtin_amdgcn_readlane(iv, 48));
    return (a + b) + (c + d);
}
DI float grp_max16(float x) {
    x = fmaxf(x, dpp_mov<0xB1>(x)); x = fmaxf(x, dpp_mov<0x4E>(x)); x = fmaxf(x, dpp_mov<0x141>(x)); x = fmaxf(x, dpp_mov<0x140>(x)); return x;
}
#define LDS_FENCE() do { asm volatile("s_waitcnt lgkmcnt(0)" ::: "memory"); __builtin_amdgcn_wave_barrier(); asm volatile("" ::: "memory"); } while (0)

struct Params { const float* in[30]; float* out; unsigned char* ws; };

typedef __attribute__((address_space(4))) const Params* KArg;
struct Ctx {
    KArg p; int layer; int tid, lane, wave, G, bid;
    unsigned char* ws; unsigned char* lds;
    DI const float* in(int i) const { return p->in[i]; }
};
typedef f32x4 Acc[2][2][4][2];
struct EpiZ {
    static constexpr bool PERM = true, AFTER_DRAIN = false;
    bf16_t *ZA, *ZR, *ZT; const float *rc, *rs;
    DI void operator()(const Acc& acc, const pg8::Unit& u, int wr, int wc, int fr_, int fq_) const {
        int fr = fr_, fq = fq_; asm volatile("" : "+v"(fr), "+v"(fq));
        const int pn = u.pn; bf16_t* base; int ld, colt; bool rope = false; float qs = 1.f;
        if (pn < 7) { base = ZA; ld = ZAW; colt = pn * 256; }
        else if (pn < 11) { base = ZR; ld = 1024; colt = (pn - 7) * 256; }
        else { base = ZT; ld = 2304; colt = (pn - 11) * 256; rope = pn < 17; qs = pn < 14 ? 0.125f : 1.f; }
        const int row0 = u.pm * 256 + wr * 64 + fr;
        if (!rope) {
#pragma unroll
            for (int ai = 0; ai < 2; ++ai)
#pragma unroll
                for (int m = 0; m < 4; ++m) {
                    bf16_t* rowp = base + (size_t)(row0 + ai * 128 + m * 16) * ld + colt;
#pragma unroll
                    for (int bj = 0; bj < 2; ++bj) {
                        const f32x4 v0 = acc[ai][bj][m][0], v1 = acc[ai][bj][m][1]; u32x4 w;
                        w.x = pk2(v0[0], v0[1]); w.y = pk2(v0[2], v0[3]); w.z = pk2(v1[0], v1[1]); w.w = pk2(v1[2], v1[3]);
                        *(u32x4*)(rowp + bj * 128 + wc * 32 + 8 * fq) = w;
                    }
                }
        } else {
#pragma unroll
            for (int ai = 0; ai < 2; ++ai)
#pragma unroll
              for (int mp = 0; mp < 2; ++mp) {
                f32x4 cs[2][4];
#pragma unroll
                for (int mm = 0; mm < 2; ++mm) { const int pos = (row0 + ai * 128 + (2 * mp + mm) * 16) & (SEQ - 1);
                    cs[mm][0] = *(const f32x4*)(rc + pos * 32 + 8 * fq); cs[mm][1] = *(const f32x4*)(rc + pos * 32 + 8 * fq + 4);
                    cs[mm][2] = *(const f32x4*)(rs + pos * 32 + 8 * fq); cs[mm][3] = *(const f32x4*)(rs + pos * 32 + 8 * fq + 4); }
                asm volatile("" ::: "memory");
#pragma unroll
                for (int mm = 0; mm < 2; ++mm) {
                    const int m = 2 * mp + mm;
                    bf16_t* rowp = base + (size_t)(row0 + ai * 128 + m * 16) * ld + colt;
                    const f32x4 c0 = cs[mm][0], c1 = cs[mm][1], s0 = cs[mm][2], s1 = cs[mm][3];
                    const f32x4 a0 = acc[ai][0][m][0], a1 = acc[ai][0][m][1], b0 = acc[ai][1][m][0], b1 = acc[ai][1][m][1];
                    const f32x4 o10 = (a0 * c0 - b0 * s0) * qs, o11 = (a1 * c1 - b1 * s1) * qs;
                    const f32x4 o20 = (a0 * s0 + b0 * c0) * qs, o21 = (a1 * s1 + b1 * c1) * qs;
                    u32x4 w1, w2;
                    w1.x = pk2(o10[0], o10[1]); w1.y = pk2(o10[2], o10[3]); w1.z = pk2(o11[0], o11[1]); w1.w = pk2(o11[2], o11[3]);
                    w2.x = pk2(o20[0], o20[1]); w2.y = pk2(o20[2], o20[3]); w2.z = pk2(o21[0], o21[1]); w2.w = pk2(o21[2], o21[3]);
                    *(u32x4*)(rowp + wc * 64 + 8 * fq) = w1;
                    *(u32x4*)(rowp + wc * 64 + 32 + 8 * fq) = w2;
                }
                asm volatile("" ::: "memory");
              }
        }
    }
};
template <int ACT  > struct EpiSplit {
    static constexpr bool PERM = true, AFTER_DRAIN = false;
    bf16_t* O; int ld; int tiles_per; size_t stride;
    DI void operator()(const Acc& acc, const pg8::Unit& u, int wr, int wc, int fr_, int fq_) const {
        int fr = fr_, fq = fq_; asm volatile("" : "+v"(fr), "+v"(fq));
        const int t = u.pn / tiles_per, colt = (u.pn - t * tiles_per) * 256;
        bf16_t* base = O + (size_t)t * stride;
        const int row0 = u.pm * 256 + wr * 64 + fr;
#pragma unroll
        for (int ai = 0; ai < 2; ++ai)
#pragma unroll
            for (int m = 0; m < 4; ++m) {
                bf16_t* rowp = base + (size_t)(row0 + ai * 128 + m * 16) * ld + colt + wc * 32 + 8 * fq;
#pragma unroll
                for (int bj = 0; bj < 2; ++bj) {
                    f32x4 v0 = acc[ai][bj][m][0], v1 = acc[ai][bj][m][1];
                    if (ACT == 1) {
#pragma unroll
                        for (int j = 0; j < 4; ++j) { v0[j] = sigmoidf_(v0[j]); v1[j] = sigmoidf_(v1[j]); }
                    }
                    u32x4 w; w.x = pk2(v0[0], v0[1]); w.y = pk2(v0[2], v0[3]); w.z = pk2(v1[0], v1[1]); w.w = pk2(v1[2], v1[3]);
                    *(u32x4*)(rowp + bj * 128) = w;
                }
            }
    }
};
struct EpiProj {
    static constexpr bool PERM = true, AFTER_DRAIN = false;
    bf16_t* gates; float* mf;
    DI void operator()(const Acc& acc, const pg8::Unit& u, int wr, int wc, int fr_, int fq_) const {
        int fr = fr_, fq = fq_; asm volatile("" : "+v"(fr), "+v"(fq));
        const int n = u.pm >> 6, pm = u.pm & 63, pn = u.pn & 3;
        const bf16_t* gs = gates + (size_t)n * T * 1024;
        const int row0 = pm * 256 + wr * 64 + fr, col0 = pn * 256 + wc * 32 + 8 * fq;
#pragma unroll
        for (int ai = 0; ai < 2; ++ai)
#pragma unroll
            for (int m = 0; m < 4; ++m)
#pragma unroll
                for (int bj = 0; bj < 2; ++bj) {
                    const size_t off = (size_t)(row0 + ai * 128 + m * 16) * 1024 + col0 + bj * 128;
                    float g[8]; unpack8(*(const u32x4*)(gs + off), g);
                    const f32x4 v0 = acc[ai][bj][m][0], v1 = acc[ai][bj][m][1];
                    f32x4 r0 = (f32x4){g[0] * v0[0], g[1] * v0[1], g[2] * v0[2], g[3] * v0[3]};
                    f32x4 r1 = (f32x4){g[4] * v1[0], g[5] * v1[1], g[6] * v1[2], g[7] * v1[3]};
                    if (n > 0) { r0 += *(const f32x4*)(mf + off); r1 += *(const f32x4*)(mf + off + 4); }
                    if (n < 3) { *(f32x4*)(mf + off) = r0; *(f32x4*)(mf + off + 4) = r1; }
                    else { u32x4 w; w.x = pk2(r0[0], r0[1]); w.y = pk2(r0[2], r0[3]); w.z = pk2(r1[0], r1[1]); w.w = pk2(r1[2], r1[3]); *(u32x4*)(gates + off) = w; }
                }
    }
};
struct EpiGateMerge {
    static constexpr bool PERM = true, AFTER_DRAIN = false;
    const bf16_t* proj; bf16_t* merged;
    DI void operator()(const Acc& acc, const pg8::Unit& u, int wr, int wc, int fr_, int fq_) const {
        int fr = fr_, fq = fq_; asm volatile("" : "+v"(fr), "+v"(fq));
        const int row0 = u.pm * 256 + wr * 64 + fr, d0 = u.pn * 64 + wc * 16 + fq * 4;
#pragma unroll
        for (int ai = 0; ai < 2; ++ai)
#pragma unroll
            for (int m = 0; m < 4; ++m) {
                const size_t off = (size_t)(row0 + ai * 128 + m * 16) * 1024 + d0;
                f32x4 r = (f32x4){0.f, 0.f, 0.f, 0.f};
#pragma unroll
                for (int bj = 0; bj < 2; ++bj)
#pragma unroll
                    for (int nn = 0; nn < 2; ++nn) {
                        const u32x2 pw = *(const u32x2*)(proj + (size_t)(2 * bj + nn) * T * 1024 + off);
                        const f32x4 g = acc[ai][bj][m][nn];
                        r[0] += sigmoidf_(g[0]) * bflo(pw.x); r[1] += sigmoidf_(g[1]) * bfhi(pw.x); r[2] += sigmoidf_(g[2]) * bflo(pw.y); r[3] += sigmoidf_(g[3]) * bfhi(pw.y);
                    }
                u32x2 w; w.x = pk2(r[0], r[1]); w.y = pk2(r[2], r[3]);
                *(u32x2*)(merged + off) = w;
                asm volatile("" ::: "memory");
            }
    }
};
struct ProjOrder {
    int G, c;
    DI bool next(int i, pg8::Unit& u) const { const int j = c + (i >> 2) * G; if (j >= 256) return false; const int n = i & 3; u.pm = n * 64 + (j >> 2); u.pn = n * 4 + (j & 3); return true; }
    DI void a_ready(const pg8::Unit&) const {}
    DI void done(const pg8::Unit&) const {}
};
struct GateOrder {
    int G, c;
    DI bool next(int i, pg8::Unit& u) const { const int j = c + (i >> 2) * G; if (j >= 256) return false; u.pm = j >> 2; u.pn = (j & 3) * 4 + (i & 3); return true; }
    DI void a_ready(const pg8::Unit&) const {}
    DI void done(const pg8::Unit&) const {}
};
template <bool EMIT> struct EpiRes {
    static constexpr bool PERM = false, AFTER_DRAIN = false;
    const float* res; float* out; bf16_t* xb; float* ssq;
    DI void operator()(const Acc& acc, const pg8::Unit& u, int wr, int wc, int fr_, int fq_) const {
        int fr = fr_, fq = fq_; asm volatile("" : "+v"(fr), "+v"(fq));
        const int row0 = u.pm * 256 + wr * 64 + fr, col0 = u.pn * 256 + wc * 32 + 4 * fq;
        const int lane = fq * 16 + fr;
#pragma unroll
        for (int ai = 0; ai < 2; ++ai)
#pragma unroll
            for (int m = 0; m < 4; ++m) {
                const int row = row0 + ai * 128 + m * 16; float sq = 0.f;
#pragma unroll
                for (int bj = 0; bj < 2; ++bj)
#pragma unroll
                    for (int n = 0; n < 2; ++n) {
                        const size_t off = (size_t)row * 1024 + col0 + bj * 128 + n * 16;
                        const f32x4 o = *(const f32x4*)(res + off) + acc[ai][bj][m][n];
                        *(f32x4*)(out + off) = o;
                        if (EMIT) { sq += (o[0] * o[0] + o[1] * o[1]) + (o[2] * o[2] + o[3] * o[3]); u32x2 w; w.x = pk2(o[0], o[1]); w.y = pk2(o[2], o[3]); *(u32x2*)(xb + off) = w; }
                    }
                if (EMIT) {
                    sq += __int_as_float(__builtin_amdgcn_ds_bpermute((lane ^ 16) << 2, __float_as_int(sq)));
                    sq += __int_as_float(__builtin_amdgcn_ds_bpermute((lane ^ 32) << 2, __float_as_int(sq)));
                    if (fq == 0) ssq[row * 16 + u.pn * 4 + wc] = sq;
                }
            }
    }
};
struct EpiUp {
    static constexpr bool PERM = true, AFTER_DRAIN = false;
    bf16_t* O; const float* ssq;
    DI void operator()(const Acc& acc, const pg8::Unit& u, int wr, int wc, int fr_, int fq_) const {
        int fr = fr_, fq = fq_; asm volatile("" : "+v"(fr), "+v"(fq));
        const int t = u.pn / 11, colt = (u.pn - t * 11) * 256;
        bf16_t* base = O + (size_t)t * T * DFF;
        const int row0 = u.pm * 256 + wr * 64 + fr, lane = fq * 16 + fr;
        f32x4 part[2][4];
#pragma unroll
        for (int ai = 0; ai < 2; ++ai)
#pragma unroll
            for (int m = 0; m < 4; ++m) part[ai][m] = *(const f32x4*)(ssq + (size_t)(row0 + ai * 128 + m * 16) * 16 + fq * 4);
#pragma unroll
        for (int ai = 0; ai < 2; ++ai)
#pragma unroll
            for (int m = 0; m < 4; ++m) {
                const int row = row0 + ai * 128 + m * 16;
                float sq = (part[ai][m][0] + part[ai][m][1]) + (part[ai][m][2] + part[ai][m][3]);
                sq += __int_as_float(__builtin_amdgcn_ds_bpermute((lane ^ 16) << 2, __float_as_int(sq)));
                sq += __int_as_float(__builtin_amdgcn_ds_bpermute((lane ^ 32) << 2, __float_as_int(sq)));
                const float rstd = rsqrtf(sq * (1.f / DM) + NEPS);
                bf16_t* rowp = base + (size_t)row * DFF + colt + wc * 32 + 8 * fq;
#pragma unroll
                for (int bj = 0; bj < 2; ++bj) {
                    const f32x4 v0 = acc[ai][bj][m][0] * rstd, v1 = acc[ai][bj][m][1] * rstd;
                    u32x4 w; w.x = pk2(v0[0], v0[1]); w.y = pk2(v0[2], v0[3]); w.z = pk2(v1[0], v1[1]); w.w = pk2(v1[2], v1[3]);
                    *(u32x4*)(rowp + bj * 128) = w;
                }
            }
    }
};
struct EpiUpAct {
    static constexpr bool PERM = true, AFTER_DRAIN = false;
    bf16_t* act; const float* ssq; const float* cw; const float* cb; float* edge; PG8_LAS float* halo;
    DI void operator()(const Acc& acc, const pg8::Unit& u, int wr, int wc, int fr_, int fq_) const {
        int fr = fr_, fq = fq_; asm volatile("" : "+v"(fr), "+v"(fq));
        const int lane = fq * 16 + fr, fl = wc * 32 + 8 * fq, f0 = u.pn * 128 + fl;
        const int row0 = u.pm * 256 + wr * 64 + fr;
        float rstd[2][4];
        {
            f32x4 part[2][4];
#pragma unroll
            for (int ai = 0; ai < 2; ++ai)
#pragma unroll
                for (int m = 0; m < 4; ++m) part[ai][m] = *(const f32x4*)(ssq + (size_t)(row0 + ai * 128 + m * 16) * 16 + fq * 4);
#pragma unroll
            for (int ai = 0; ai < 2; ++ai)
#pragma unroll
                for (int m = 0; m < 4; ++m) {
                    float sq = (part[ai][m][0] + part[ai][m][1]) + (part[ai][m][2] + part[ai][m][3]);
                    sq += __int_as_float(__builtin_amdgcn_ds_bpermute((lane ^ 16) << 2, __float_as_int(sq)));
                    sq += __int_as_float(__builtin_amdgcn_ds_bpermute((lane ^ 32) << 2, __float_as_int(sq)));
                    rstd[ai][m] = rsqrtf(sq * (1.f / DM) + NEPS);
                }
        }
#pragma unroll
        for (int ai = 0; ai < 2; ++ai)
            if (fr >= 14) {
                PG8_LAS float* hp = halo + ((ai * 2 + wr) * 2 + (fr - 14)) * 128 + fl;
                *(PG8_LAS f32x4*)(hp) = acc[ai][0][3][0] * rstd[ai][3]; *(PG8_LAS f32x4*)(hp + 4) = acc[ai][0][3][1] * rstd[ai][3];
            }
        asm volatile("s_waitcnt lgkmcnt(0)" ::: "memory"); __builtin_amdgcn_s_barrier(); asm volatile("" ::: "memory");
        float w0[8], w1[8], w2[8], bb[8];
#pragma unroll
        for (int e = 0; e < 8; e += 4) { *(f32x4*)(w0 + e) = *(const f32x4*)(cw + f0 + e); *(f32x4*)(w1 + e) = *(const f32x4*)(cw + DFF + f0 + e); *(f32x4*)(w2 + e) = *(const f32x4*)(cw + 2 * DFF + f0 + e); *(f32x4*)(bb + e) = *(const f32x4*)(cb + f0 + e); }
        const int src1 = (((fr - 1) & 15) | (fq << 4)) << 2, src2 = (((fr - 2) & 15) | (fq << 4)) << 2;
#pragma unroll
        for (int ai = 0; ai < 2; ++ai) {
            float p1[8], p2[8];
            if (wr == 1 || ai == 1) {
                const PG8_LAS float* hb = halo + (((wr == 1 ? ai : 0) * 2 + (wr == 1 ? 0 : 1)) * 2) * 128 + fl;
                const f32x4 a0 = *(const PG8_LAS f32x4*)(hb), a1 = *(const PG8_LAS f32x4*)(hb + 4), b0 = *(const PG8_LAS f32x4*)(hb + 128), b1 = *(const PG8_LAS f32x4*)(hb + 132);
#pragma unroll
                for (int e = 0; e < 4; ++e) { p1[e] = b0[e]; p1[4 + e] = b1[e]; p2[e] = (fr == 0) ? a0[e] : b0[e]; p2[4 + e] = (fr == 0) ? a1[e] : b1[e]; }
            } else {
#pragma unroll
                for (int e = 0; e < 8; ++e) { p1[e] = 0.f; p2[e] = 0.f; }
            }
#pragma unroll
            for (int m = 0; m < 4; ++m) {
                const int row = row0 + ai * 128 + m * 16; const float rs = rstd[ai][m];
                float uu[8], gg[8], a[8];
#pragma unroll
                for (int e = 0; e < 4; ++e) { uu[e] = acc[ai][0][m][0][e] * rs; uu[4 + e] = acc[ai][0][m][1][e] * rs; gg[e] = acc[ai][1][m][0][e] * rs; gg[4 + e] = acc[ai][1][m][1][e] * rs; }
#pragma unroll
                for (int e = 0; e < 8; ++e) {
                    const float c1 = __int_as_float(__builtin_amdgcn_ds_bpermute(src1, __float_as_int(uu[e])));
                    const float c2 = __int_as_float(__builtin_amdgcn_ds_bpermute(src2, __float_as_int(uu[e])));
                    const float u1 = (fr >= 1) ? c1 : p1[e], u2 = (fr >= 2) ? c2 : p2[e];
                    p1[e] = c1; p2[e] = c2;
                    a[e] = siluf_(bb[e] + w0[e] * uu[e] + w1[e] * u1 + w2[e] * u2) * gg[e];
                }
                *(u32x4*)(act + (size_t)row * DFF + f0) = pack8(a);
                if (ai == 0 && m == 0 && wr == 0 && fr < 2) {
                    float* e2 = edge + (size_t)(u.pm * 6 + 2 + fr) * DFF + f0; float* e4 = edge + (size_t)(u.pm * 6 + 4 + fr) * DFF + f0;
                    *(f32x4*)(e2) = *(f32x4*)uu; *(f32x4*)(e2 + 4) = *(f32x4*)(uu + 4); *(f32x4*)(e4) = *(f32x4*)gg; *(f32x4*)(e4 + 4) = *(f32x4*)(gg + 4);
                }
                if (ai == 1 && m == 3 && wr == 1 && fr >= 14) {
                    float* e0 = edge + (size_t)(u.pm * 6 + (fr - 14)) * DFF + f0;
                    *(f32x4*)(e0) = *(f32x4*)uu; *(f32x4*)(e0 + 4) = *(f32x4*)(uu + 4);
                }
            }
        }
    }
};
DI void ffn_edge_fixup(const Ctx& C, int pm) {
    if ((pm & 15) == 0) return;
    const int L = C.layer;
    const float* cw = C.in(27) + (size_t)L * 3 * DFF; const float* cb = C.in(28) + (size_t)L * DFF;
    const float* cur = (const float*)(C.ws + WS_EDGE) + (size_t)pm * 6 * DFF; const float* prev = cur - 6 * DFF;
    bf16_t* act = (bf16_t*)(C.ws + WS_ACT);
    for (int idx = C.tid; idx < 2 * DFF; idx += 512) {
        const int i = idx >= DFF ? 1 : 0, f = idx - i * DFF;
        const float u0 = cur[(2 + i) * DFF + f], u1 = i ? cur[2 * DFF + f] : prev[DFF + f], u2 = i ? prev[DFF + f] : prev[f], g = cur[(4 + i) * DFF + f];
        const float v = cb[f] + cw[f] * u0 + cw[DFF + f] * u1 + cw[2 * DFF + f] * u2;
        act[(size_t)(pm * 256 + i) * DFF + f] = f2bf(siluf_(v) * g);
    }
}
DI void transpose_item(const float* W, int K, int Nsrc, int c0, int ncols, bf16_t* WT, int row0, int permq, float* scr, int item, int lane, const float* ksc) {
    const int nblk = (ncols + 31) >> 5, kb = item / nblk, nb = item - kb * nblk, k0 = 64 * kb, n0 = 32 * nb;
    const int ncol = n0 + (lane & 31);
#pragma unroll 8
    for (int i = 0; i < 32; ++i) { const int kk = 2 * i + (lane >> 5); const float sc = ksc ? ksc[k0 + kk] : 1.f; scr[kk * 33 + (lane & 31)] = (ncol < ncols) ? W[(size_t)(k0 + kk) * Nsrc + c0 + ncol] * sc : 0.f; }
    LDS_FENCE();
    const int c = lane & 7;
#pragma unroll
    for (int j = 0; j < 4; ++j) {
        const int n = (lane >> 3) + 8 * j, col = n0 + n;
        if (col < ncols) {
            int lr = col;
            if (col < permq) { const int jl = col & 255; lr = (col & ~255) + ((jl >> 5) & 1) * 128 + (jl >> 6) * 32 + (jl & 31); }
            if (permq == -2) { const int isg = col >= DFF ? 1 : 0, f = col - isg * DFF; lr = (f >> 7) * 256 + isg * 128 + (f & 127); }
            if (permq == -1) { const int n = col >> 10, d = col & 1023, dl = d & 63; lr = (d >> 6) * 256 + 128 * (n >> 1) + 32 * (dl >> 4) + 8 * ((dl >> 2) & 3) + 4 * (n & 1) + (dl & 3); }
            const float* s = scr + (8 * c) * 33 + n;
            u32x4 o; o.x = pk2(s[0 * 33], s[1 * 33]); o.y = pk2(s[2 * 33], s[3 * 33]); o.z = pk2(s[4 * 33], s[5 * 33]); o.w = pk2(s[6 * 33], s[7 * 33]);
            *(u32x4*)(WT + (size_t)(row0 + lr) * K + k0 + 8 * c) = o;
        }
    }
    LDS_FENCE();
}
DI void rmsnorm_rows_bf16(const Ctx& C, const float* x, const float* w, bf16_t* o) {
    const int gw = C.bid * 8 + C.wave, NGW = C.G * 8;
    f32x4 wv[4];
#pragma unroll
    for (int j = 0; j < 4; ++j) wv[j] = *(const f32x4*)(w + 4 * C.lane + 256 * j);
    for (int m = gw; m < T; m += 2 * NGW) {
        const int m2 = m + NGW; const bool two = m2 < T;
        const float* xr = x + (size_t)m * DM + 4 * C.lane; const float* xr2 = x + (size_t)(two ? m2 : m) * DM + 4 * C.lane;
        f32x4 v[4], u[4]; float s = 0.f, s2 = 0.f;
#pragma unroll
        for (int j = 0; j < 4; ++j) { v[j] = *(const f32x4*)(xr + 256 * j); u[j] = *(const f32x4*)(xr2 + 256 * j); }
        asm volatile("" ::: "memory");
#pragma unroll
        for (int j = 0; j < 4; ++j) { s += (v[j][0] * v[j][0] + v[j][1] * v[j][1]) + (v[j][2] * v[j][2] + v[j][3] * v[j][3]); s2 += (u[j][0] * u[j][0] + u[j][1] * u[j][1]) + (u[j][2] * u[j][2] + u[j][3] * u[j][3]); }
        const float rstd = rsqrtf(wave_sum(s) * (1.f / DM) + NEPS), rstd2 = rsqrtf(wave_sum(s2) * (1.f / DM) + NEPS);
        bf16_t* orow = o + (size_t)m * DM + 4 * C.lane;
#pragma unroll
        for (int j = 0; j < 4; ++j) { u32x2 pk; pk.x = pk2(v[j][0] * rstd * wv[j][0], v[j][1] * rstd * wv[j][1]); pk.y = pk2(v[j][2] * rstd * wv[j][2], v[j][3] * rstd * wv[j][3]); *(u32x2*)(orow + 256 * j) = pk; }
        if (two) {
            bf16_t* orow2 = o + (size_t)m2 * DM + 4 * C.lane;
#pragma unroll
            for (int j = 0; j < 4; ++j) { u32x2 pk; pk.x = pk2(u[j][0] * rstd2 * wv[j][0], u[j][1] * rstd2 * wv[j][1]); pk.y = pk2(u[j][2] * rstd2 * wv[j][2], u[j][3] * rstd2 * wv[j][3]); *(u32x2*)(orow2 + 256 * j) = pk; }
        }
    }
}
constexpr int CI0 = 16 * 56, CIa = 16, CI1 = 16 * 28, CI2 = 16 * 72, CI3 = 16 * 128, CI4 = 4 * 32, CI8 = 16 * 32, CI9 = 16 * 176, CI10 = 44 * 32;
constexpr int CONV_WZ = CI0 + CIa + CI1 + CI2, CONV_REST = CI3 + 4 * CI4 + CI8 + CI9 + CI10;
DI void conv_item(const Ctx& C, int LW, int set, int it, float* scr) {
    const float* W; const float* ksc = nullptr; int K = 1024, Nsrc = NIN, c0 = 0, ncols, row0 = 0, permq = 0; size_t dst; int r = it;
    if (set == 0) {
        W = C.in(4) + (size_t)LW * DM * NIN; dst = WS_WZ;
        if (r < CI0) { ncols = ZAW; }
        else if (r < CI0 + CIa) { r -= CI0; c0 = 1792; ncols = 16; row0 = ZAW + 896; }
        else if (r < CI0 + CIa + CI1) { r -= CI0 + CIa; c0 = 1808; ncols = 896; row0 = ZAW; }
        else { r -= CI0 + CIa + CI1; c0 = 2704; ncols = 2304; row0 = ZAW + 1024; permq = 1536; }
    } else if (r < CI3) { W = C.in(4) + (size_t)LW * DM * NIN; dst = WS_WG; c0 = 5008; ncols = 4096; permq = -1; }
    else if (r < CI3 + 4 * CI4) { r -= CI3; const int n = r / CI4; r -= n * CI4; W = C.in(24) + (size_t)LW * 4 * 256 * 1024 + (size_t)n * 256 * 1024; K = 256; Nsrc = 1024; ncols = 1024; dst = WS_WB; row0 = n * 1024; }
    else if (r < CI3 + 4 * CI4 + CI8) { r -= CI3 + 4 * CI4; W = C.in(25) + (size_t)LW * DM * DM; Nsrc = 1024; ncols = 1024; dst = WS_WO; }
    else if (r < CI3 + 4 * CI4 + CI8 + CI9) { r -= CI3 + 4 * CI4 + CI8; W = C.in(26) + (size_t)LW * DM * 2 * DFF; Nsrc = 2 * DFF; ncols = 2 * DFF; dst = WS_WUP; ksc = C.in(2) + LW * DM; permq = -2; }
    else { r -= CI3 + 4 * CI4 + CI8 + CI9; W = C.in(29) + (size_t)LW * DFF * DM; K = DFF; Nsrc = 1024; ncols = 1024; dst = WS_WDN; }
    transpose_item(W, K, Nsrc, c0, ncols, (bf16_t*)(C.ws + dst), row0, permq, scr, r, C.lane, ksc);
}
DI void phase_A(const Ctx& C) {
    const int L = C.layer;
    float* scr = (float*)(C.lds + C.wave * 16384);
    const int gw = C.bid * 8 + C.wave, NGW = C.G * 8;
    bf16_t* WZ = (bf16_t*)(C.ws + WS_WZ);
    if (L == 0) {
        for (int it = gw; it < CONV_WZ; it += NGW) conv_item(C, 0, 0, it, scr);
    for (int i = C.bid * 512 + C.tid; i < 112 * 128; i += C.G * 512) {
        const int rr = i >> 7, ch = i & 127; const int row = ZAW + 912 + rr;
        *(u32x4*)(WZ + (size_t)row * 1024 + ch * 8) = (u32x4){0u, 0u, 0u, 0u};
    }
        float* rc = (float*)(C.ws + WS_ROPEC); float* rs = (float*)(C.ws + WS_ROPES);
        for (int i = C.bid * 512 + C.tid; i < SEQ * 32; i += C.G * 512) {
            const int pos = i >> 5, j = i & 31;
            const float inv = (float)pow(10000.0, -(double)j / 32.0);
            const float ang = (float)pos * inv;
            rc[i] = cosf(ang); rs[i] = sinf(ang);
        }
    }
    const float* x = (L == 0) ? C.in(0) : C.p->out;
    rmsnorm_rows_bf16(C, x, C.in(1) + L * DM, (L == 0) ? (bf16_t*)C.p->out : (bf16_t*)(C.ws + WS_XN));
}

DI bf16_t* rw_slot(const Ctx& C, int s) { return (bf16_t*)(C.ws + WS_RW + (size_t)s * SLOT); }
DI void phase_C(const Ctx& C) {
    const int L = C.layer;
    float* zs = (float*)C.lds;
    float* vv1 = zs + 16 * 896;
    const bf16_t* ZR = (const bf16_t*)(C.ws + WS_OM);
    const float* mu = C.in(10) + L * 896;
    const float* w0 = C.in(11) + L * 256; const float* w2 = C.in(12) + L * 32 * 256;
    const float* a0 = C.in(13) + L * 256; const float* a2 = C.in(14) + L * 32 * 256;
    const float* g2 = C.in(15) + L * 64 * 256;
    const float* k_k = C.in(16) + L * 256; const float* k_a = C.in(17) + L * 256; const float* r_k = C.in(18) + L * 256;
    const float* v0 = C.in(21); const float* v1 = C.in(22); const float* v2 = C.in(23);
    bf16_t* Sg = rw_slot(C, 0); bf16_t* Sr = rw_slot(C, 2); bf16_t* Sw = rw_slot(C, 3); bf16_t* Sk = rw_slot(C, 4); bf16_t* Skk = rw_slot(C, 5); bf16_t* Sb = rw_slot(C, 6);
    bf16_t* VRW = (bf16_t*)(C.ws + WS_VRW); float* BON = (float*)(C.ws + WS_BONUS);
    const int c = C.tid & 255, th = C.tid >> 8, h = c >> 6;
    const float cw0 = w0[c], ca0 = a0[c], ckk = k_k[c], cka = k_a[c], crk = r_k[c], cv0 = (L > 0) ? v0[c] : 0.f;
    float* OUT = vv1 + 16 * 32;
    const int l15 = C.lane & 15, k8 = (C.lane >> 4) * 8;
    bf16x8 Bw[2], Ba[2], Bg[2][2], Bv2[2], Bv1[2];
#pragma unroll
    for (int cb = 0; cb < 2; ++cb) {
        const int col = C.wave * 32 + cb * 16 + l15; float f[8];
#pragma unroll
        for (int e = 0; e < 8; ++e) f[e] = w2[(k8 + e) * 256 + col];
        Bw[cb] = __builtin_bit_cast(bf16x8, pack8(f));
#pragma unroll
        for (int e = 0; e < 8; ++e) f[e] = a2[(k8 + e) * 256 + col];
        Ba[cb] = __builtin_bit_cast(bf16x8, pack8(f));
#pragma unroll
        for (int ks = 0; ks < 2; ++ks) {
#pragma unroll
            for (int e = 0; e < 8; ++e) f[e] = g2[(ks * 32 + k8 + e) * 256 + col];
            Bg[cb][ks] = __builtin_bit_cast(bf16x8, pack8(f));
        }
#pragma unroll
        for (int e = 0; e < 8; ++e) f[e] = (L > 0) ? v2[(k8 + e) * 256 + col] : 0.f;
        Bv2[cb] = __builtin_bit_cast(bf16x8, pack8(f));
#pragma unroll
        for (int e = 0; e < 8; ++e) f[e] = (L > 0) ? v1[(C.wave * 32 + k8 + e) * 32 + cb * 16 + l15] : 0.f;
        Bv1[cb] = __builtin_bit_cast(bf16x8, pack8(f));
    }
    for (int tile = C.bid; tile < T / 16; tile += C.G) {
        const int t0 = tile * 16;
        __syncthreads();
        {
            const int tok = C.tid >> 5, c4 = (C.tid & 31) * 4; const size_t t = (size_t)(t0 + tok);
            float al[16]; unpack8(*(const u32x4*)(ZR + t * 1024 + 896), al); unpack8(*(const u32x4*)(ZR + t * 1024 + 904), al + 8);
            const float* aw2 = C.in(7) + L * 16 * 128; const float* ab = C.in(8) + L * 128;
            f32x4 x = *(const f32x4*)(ab + c4);
#pragma unroll
            for (int j = 0; j < 16; ++j) x += al[j] * *(const f32x4*)(aw2 + j * 128 + c4);
            float la[4];
#pragma unroll
            for (int e = 0; e < 4; ++e) la[e] = (fminf(x[e], 0.f) - __logf(1.f + __expf(-fabsf(x[e])))) * 0.0625f;
            u32x2 w; w.x = pk2(la[0], la[1]); w.y = pk2(la[2], la[3]);
            *(u32x2*)(rw_slot(C, 1) + t * 128 + c4) = w;
        }
        {
            u32x4 zr[4], zq[4];
#pragma unroll
            for (int i = 0; i < 4; ++i) {
                const int idx = C.tid + 512 * i; zr[i] = (u32x4){0u, 0u, 0u, 0u}; zq[i] = zr[i];
                if (idx < 16 * 112) { const int tok = idx / 112, ch = idx - tok * 112, t = t0 + tok;
                    zr[i] = *(const u32x4*)(ZR + (size_t)t * 1024 + ch * 8);
                    if ((t & (SEQ - 1)) != 0) zq[i] = *(const u32x4*)(ZR + (size_t)(t - 1) * 1024 + ch * 8); }
            }
#pragma unroll
            for (int i = 0; i < 4; ++i) {
                const int idx = C.tid + 512 * i;
                if (idx < 16 * 112) {
                    const int tok = idx / 112, ch = idx - tok * 112, col = ch * 8;
                    float z[8], zp[8], m[8];
                    unpack8(zr[i], z); unpack8(zq[i], zp);
                    *(f32x4*)m = *(const f32x4*)(mu + col); *(f32x4*)(m + 4) = *(const f32x4*)(mu + col + 4);
#pragma unroll
                    for (int e = 0; e < 8; ++e) {
                        float v = z[e] + m[e] * (zp[e] - z[e]);
                        if (col >= 256 && col < 288) v = 1.f - 2.f * __builtin_amdgcn_rcpf(1.f + __expf(2.f * v));
                        if (col >= 832) v = sigmoidf_(v);
                        zs[tok * 896 + col + e] = v;
                    }
                }
            }
        }
        __syncthreads();
        const f32x4 zero4 = (f32x4){0.f, 0.f, 0.f, 0.f};
        const float* zrow = zs + l15 * 896 + k8;
#define AFRAG(p) __builtin_bit_cast(bf16x8, pack8(p))
        if (L > 0) {
            float* P = OUT + C.wave * 512;
            const bf16x8 av_ = AFRAG(zrow + 544 + C.wave * 32);
#pragma unroll
            for (int cb = 0; cb < 2; ++cb) {
                const f32x4 r = __builtin_amdgcn_mfma_f32_16x16x32_bf16(av_, Bv1[cb], zero4, 0, 0, 0);
#pragma unroll
                for (int j = 0; j < 4; ++j) P[((C.lane >> 4) * 4 + j) * 32 + cb * 16 + l15] = r[j];
            }
            __syncthreads();
            { float a = 0.f;
#pragma unroll
              for (int w = 0; w < 8; ++w) a += OUT[w * 512 + C.tid]; vv1[C.tid] = a; }
        }
        __syncthreads();
        {
            const bf16x8 a_w = AFRAG(zrow + 256), a_a = AFRAG(zrow + 800), a_g0 = AFRAG(zrow + 832), a_g1 = AFRAG(zrow + 864), a_v = AFRAG(vv1 + l15 * 32 + k8);
#pragma unroll
            for (int cb = 0; cb < 2; ++cb) {
                const f32x4 rw = __builtin_amdgcn_mfma_f32_16x16x32_bf16(a_w, Bw[cb], zero4, 0, 0, 0);
                const f32x4 ra = __builtin_amdgcn_mfma_f32_16x16x32_bf16(a_a, Ba[cb], zero4, 0, 0, 0);
                f32x4 rg = __builtin_amdgcn_mfma_f32_16x16x32_bf16(a_g0, Bg[cb][0], zero4, 0, 0, 0);
                rg = __builtin_amdgcn_mfma_f32_16x16x32_bf16(a_g1, Bg[cb][1], rg, 0, 0, 0);
                const f32x4 rv = __builtin_amdgcn_mfma_f32_16x16x32_bf16(a_v, Bv2[cb], zero4, 0, 0, 0);
                const int col = C.wave * 32 + cb * 16 + l15;
#pragma unroll
                for (int j = 0; j < 4; ++j) { float* o = OUT + (((C.lane >> 4) * 4 + j) * 4) * 256 + col; o[0] = rw[j]; o[256] = ra[j]; o[512] = rg[j]; o[768] = rv[j]; }
            }
        }
#undef AFRAG
        __syncthreads();
        float aw[8], aa[8], ag[8], av[8];
        const float* zb = zs + (th * 8) * 896;
#pragma unroll
        for (int q = 0; q < 8; ++q) { const float* o = OUT + ((th * 8 + q) * 4) * 256 + c; aw[q] = cw0 + o[0]; aa[q] = ca0 + o[256]; ag[q] = o[512]; av[q] = cv0 + o[768]; }
        float vf8[8];
#pragma unroll
        for (int q = 0; q < 8; ++q) vf8[q] = (L > 0) ? bf2f(VRW[(size_t)(t0 + th * 8 + q) * 256 + c]) : 0.f;
#pragma unroll
        for (int q = 0; q < 8; ++q) {
            const int t = t0 + th * 8 + q; const size_t o = (size_t)t * 256 + c;
            const float xw = -aw[q];
            const float sp = fmaxf(xw, 0.f) + __logf(1.f + __expf(-fabsf(xw)));
            const float wr = -sp - 0.5f;
            const float lw = -__expf(wr);
            const float a = sigmoidf_(aa[q]);
            const float r = zb[q * 896 + c], k = zb[q * 896 + 288 + c];
            float v = zb[q * 896 + 544 + c];
            if (L > 0) { const float vf = vf8[q]; v = v + (vf - v) * sigmoidf_(av[q]); }
            const float kkr = k * ckk;
            const float ss = wave_sum(kkr * kkr);
            const float kk = kkr * rsqrtf(fmaxf(ss, 1e-24f));
            const float km = k * (1.f + (a - 1.f) * cka);
            const float bon = wave_sum(r * km * crk);
            Sg[o] = f2bf(ag[q]); Sr[o] = f2bf(r); Sw[o] = f2bf(lw); Sk[o] = f2bf(km); Skk[o] = f2bf(kk); Sb[o] = f2bf(kk * a); VRW[o] = f2bf(v);
            if (C.lane == 0) BON[t * 4 + h] = bon;
        }
    }
    __syncthreads();
}
template <int MODE> struct ScanCfg {
    static constexpr int DK = (MODE == 1) ? 32 : 64, NKG = DK / 4, RPW = 64 / NKG, NVB = 4 * RPW, NARR = (MODE == 2) ? 5 : 3, TC = 32, NPARTS = 64 / NVB;
    static constexpr int NP = NKG / 4;
    static constexpr int ARR_F = TC * DK, BUF_F = NARR * ARR_F + TC * NVB + TC * NVB * NP;
};
struct StageRegs { u32x4 a[5]; u32x4 v; };
template <int MODE> DI void scan_load(const Ctx& C, StageRegs& R, int row0  , int h, int vp, int t2) {
    if (MODE == 2) {
        const int step = t2 >> 3, kc = t2 & 7; const size_t go = (size_t)(row0 + step) * 256 + h * 64 + kc * 8;
#pragma unroll
        for (int i = 0; i < 5; ++i) R.a[i] = *(const u32x4*)(rw_slot(C, 2 + i) + go);
        if (t2 < 64) { const int st = t2 >> 1, hf = t2 & 1; R.v = *(const u32x4*)((const bf16_t*)(C.ws + WS_VRW) + (size_t)(row0 + st) * 256 + h * 64 + vp * 16 + hf * 8); }
    } else if (MODE == 0) {
        const bf16_t* ZA = (const bf16_t*)(C.ws + WS_ZA);
        const int step = t2 >> 3, kc = t2 & 7; const size_t go = (size_t)(row0 + step) * ZAW + h * 64 + kc * 8;
        R.a[0] = *(const u32x4*)(ZA + go); R.a[1] = *(const u32x4*)(ZA + go + 256);
        if (t2 < 64) { const int st = t2 >> 1, hf = t2 & 1; R.v = *(const u32x4*)(ZA + (size_t)(row0 + st) * ZAW + 512 + h * 64 + vp * 16 + hf * 8); }
    } else {
        const bf16_t* ZA = (const bf16_t*)(C.ws + WS_ZA);
        const int step = t2 >> 3, k4 = (t2 & 7) * 4; const size_t ro = (size_t)(row0 + step) * ZAW;
        const u32x2 qw = *(const u32x2*)(ZA + ro + 1024 + h * 32 + k4), kw = *(const u32x2*)(ZA + ro + 1152 + h * 32 + k4);
        const u32x2 la = *(const u32x2*)(rw_slot(C, 1) + (size_t)(row0 + step) * 128 + h * 32 + k4);
        R.a[0] = (u32x4){qw.x, qw.y, kw.x, kw.y}; R.a[1] = (u32x4){la.x, la.y, 0u, 0u};
        if (t2 < 128) { const int st = t2 >> 2, qd = t2 & 3; R.v = *(const u32x4*)(ZA + (size_t)(row0 + st) * ZAW + 1280 + h * 64 + vp * 32 + qd * 8); }
    }
}
template <int MODE> DI void scan_commit(const Ctx& C, const StageRegs& R, float* buf, int h, int t2, const float* lbv) {
    typedef ScanCfg<MODE> S;
    float* V = buf + S::NARR * S::ARR_F;
    if (MODE == 2) {
        const int step = t2 >> 3, kc = t2 & 7; float* d = buf + step * 64 + kc * 8;
#pragma unroll
        for (int i = 0; i < 5; ++i) {
            float f[8]; unpack8(R.a[i], f);
            if (i == 1) {
#pragma unroll
                for (int e = 0; e < 8; ++e) f[e] = __expf(f[e]);
            }
            *(f32x4*)(d + i * S::ARR_F) = *(f32x4*)f; *(f32x4*)(d + i * S::ARR_F + 4) = *(f32x4*)(f + 4);
        }
        if (t2 < 64) { const int st = t2 >> 1, hf = t2 & 1; float f[8]; unpack8(R.v, f); *(f32x4*)(V + st * 16 + hf * 8) = *(f32x4*)f; *(f32x4*)(V + st * 16 + hf * 8 + 4) = *(f32x4*)(f + 4); }
    } else if (MODE == 0) {
        const int step = t2 >> 3, kc = t2 & 7; float* d = buf + step * 64 + kc * 8;
        float q[8], f[8], g[8], k[8];
        unpack8(R.a[0], q); unpack8(R.a[1], f);
#pragma unroll
        for (int e = 0; e < 8; ++e) { q[e] = siluf_(q[e]); g[e] = lbv[e] + (1.f - lbv[e]) * sigmoidf_(f[e]); k[e] = 1.f - g[e]; }
        *(f32x4*)(d) = *(f32x4*)q; *(f32x4*)(d + 4) = *(f32x4*)(q + 4);
        *(f32x4*)(d + S::ARR_F) = *(f32x4*)g; *(f32x4*)(d + S::ARR_F + 4) = *(f32x4*)(g + 4);
        *(f32x4*)(d + 2 * S::ARR_F) = *(f32x4*)k; *(f32x4*)(d + 2 * S::ARR_F + 4) = *(f32x4*)(k + 4);
        if (t2 < 64) { const int st = t2 >> 1, hf = t2 & 1; unpack8(R.v, f); *(f32x4*)(V + st * 16 + hf * 8) = *(f32x4*)f; *(f32x4*)(V + st * 16 + hf * 8 + 4) = *(f32x4*)(f + 4); }
    } else {
        const int step = t2 >> 3, k4 = (t2 & 7) * 4; float* d = buf + step * 32 + k4;
        const u32x4 lw_ = R.a[1];
        const f32x4 a = (f32x4){__expf(bflo(lw_.x)), __expf(bfhi(lw_.x)), __expf(bflo(lw_.y)), __expf(bfhi(lw_.y))};
        const float sc = 0.17677669529663687f;
        const u32x4 w = R.a[0];
        *(f32x4*)(d) = (f32x4){bflo(w.x) * sc, bfhi(w.x) * sc, bflo(w.y) * sc, bfhi(w.y) * sc};
        *(f32x4*)(d + S::ARR_F) = a;
        *(f32x4*)(d + 2 * S::ARR_F) = (f32x4){bflo(w.z), bfhi(w.z), bflo(w.w), bfhi(w.w)};
        if (t2 < 128) { const int st = t2 >> 2, qd = t2 & 3; float f[8]; unpack8(R.v, f); *(f32x4*)(V + st * 32 + qd * 8) = *(f32x4*)f; *(f32x4*)(V + st * 32 + qd * 8 + 4) = *(f32x4*)(f + 4); }
    }
}
template <int MODE> DI void scan_store(const Ctx& C, const float* buf, int row0, int h, int vp, int t2) {
    typedef ScanCfg<MODE> S;
    const float* O = buf + S::NARR * S::ARR_F + S::TC * S::NVB;
    bf16_t* OM = (bf16_t*)(C.ws + WS_OM) + (size_t)(MODE == 0 ? 0 : MODE == 1 ? 1 : 2) * T * 256;
    constexpr int CPS = S::NVB / 8;
    if (t2 < S::TC * CPS) { const int st = t2 / CPS, q = t2 % CPS; float f[8];
#pragma unroll
        for (int e = 0; e < 8; ++e) { const float* pp = O + ((st * S::NVB + q * 8 + e) * S::NP); float a = pp[0];
#pragma unroll
            for (int i = 1; i < S::NP; ++i) a += pp[i];
            f[e] = a; }
        *(u32x4*)(OM + (size_t)(row0 + st) * 256 + h * 64 + vp * S::NVB + q * 8) = pack8(f); }
}
template <int MODE> DI void scan_item(const Ctx& C, int sub) {
    typedef ScanCfg<MODE> S;
    const int bh = sub / S::NPARTS, vp = sub % S::NPARTS, b = bh >> 2, h = bh & 3;
    float* base = (float*)C.lds;
    const int t2 = C.tid - 256, rowbase = b * SEQ;
    constexpr int NC = SEQ / S::TC;
    float lbv[8];
#pragma unroll
    for (int e = 0; e < 8; ++e) lbv[e] = 0.f;
    if (MODE == 0 && C.layer > 0 && C.wave >= 4) {
        const float* tab = C.in(5); const int kc = t2 & 7;
#pragma unroll
        for (int e = 0; e < 8; ++e) { const int cc = h * 64 + kc * 8 + e; lbv[e] = sigmoidf_(tab[256 + cc] - tab[cc]); }
    }
    __syncthreads();
    StageRegs R;
    if (C.wave >= 4) { scan_load<MODE>(C, R, rowbase, h, vp, t2); scan_commit<MODE>(C, R, base, h, t2, lbv); scan_load<MODE>(C, R, rowbase + S::TC, h, vp, t2); }
    __syncthreads();
    typedef float f32x2v __attribute__((ext_vector_type(2)));
    f32x2v s01 = (f32x2v){0.f, 0.f}, s23 = (f32x2v){0.f, 0.f};
    const int kg = C.lane % S::NKG, row = C.wave * S::RPW + C.lane / S::NKG;
    for (int c = 0; c < NC; ++c) {
        float* cur = base + (c & 1) * S::BUF_F; float* nxt = base + ((c + 1) & 1) * S::BUF_F;
        if (C.wave >= 4) {
            if (c > 0) scan_store<MODE>(C, nxt, rowbase + (c - 1) * S::TC, h, vp, t2);
            if (c + 1 < NC) scan_commit<MODE>(C, R, nxt, h, t2, lbv);
            if (c + 2 < NC) scan_load<MODE>(C, R, rowbase + (c + 2) * S::TC, h, vp, t2);
        } else {
            const float* Q = cur + kg * 4; const float* V = cur + S::NARR * S::ARR_F + row;
            float* O = ((kg & 3) == 0) ? (cur + S::NARR * S::ARR_F + S::TC * S::NVB + row * S::NP + (kg >> 2)) : ((float*)(C.lds + LDS_MISC + 4096) + C.tid);
            f32x4 qn = *(const f32x4*)(Q), an = *(const f32x4*)(Q + S::ARR_F), kn = *(const f32x4*)(Q + 2 * S::ARR_F), kkn, bbn;
            f32x4 qm = *(const f32x4*)(Q + S::DK), am = *(const f32x4*)(Q + S::ARR_F + S::DK), km = *(const f32x4*)(Q + 2 * S::ARR_F + S::DK), kkm, bbm;
            if (MODE == 2) { kkn = *(const f32x4*)(Q + 3 * S::ARR_F); bbn = *(const f32x4*)(Q + 4 * S::ARR_F); kkm = *(const f32x4*)(Q + 3 * S::ARR_F + S::DK); bbm = *(const f32x4*)(Q + 4 * S::ARR_F + S::DK); }
            float vn = V[0], vm = V[S::NVB];
#pragma unroll
            for (int t = 0; t < S::TC; ++t) {
                const f32x4 q = qn, a = an, k = kn, kk = kkn, bb = bbn; const float v = vn;
                qn = qm; an = am; kn = km; kkn = kkm; bbn = bbm; vn = vm;
                if (t + 2 < S::TC) {
                    qm = *(const f32x4*)(Q + (t + 2) * S::DK); am = *(const f32x4*)(Q + S::ARR_F + (t + 2) * S::DK); km = *(const f32x4*)(Q + 2 * S::ARR_F + (t + 2) * S::DK);
                    if (MODE == 2) { kkm = *(const f32x4*)(Q + 3 * S::ARR_F + (t + 2) * S::DK); bbm = *(const f32x4*)(Q + 4 * S::ARR_F + (t + 2) * S::DK); }
                    vm = V[(t + 2) * S::NVB];
                }
#define LO2(x) __builtin_shufflevector(x, x, 0, 1)
#define HI2(x) __builtin_shufflevector(x, x, 2, 3)
                const f32x2v vv = (f32x2v){v, v};
                if (MODE == 2) {
                    f32x2v p = s01 * LO2(kk); p = s23 * HI2(kk) + p;
                    float sa = p.x + p.y;
                    const f32x2v t01 = s01 * LO2(a) + vv * LO2(k), t23 = s23 * HI2(a) + vv * HI2(k);
                    sa = -grp_sum<S::NKG>(sa);
                    const f32x2v sav = (f32x2v){sa, sa};
                    s01 = sav * LO2(bb) + t01; s23 = sav * HI2(bb) + t23;
                } else {
                    s01 = s01 * LO2(a) + vv * LO2(k); s23 = s23 * HI2(a) + vv * HI2(k);
                }
                f32x2v yp = s01 * LO2(q); yp = s23 * HI2(q) + yp;
                float y = yp.x + yp.y;
                y += dpp_mov<0xB1>(y); y += dpp_mov<0x4E>(y);
                O[t * S::NVB * S::NP] = y;
            }
        }
        __syncthreads();
    }
    if (C.wave >= 4) scan_store<MODE>(C, base + ((NC - 1) & 1) * S::BUF_F, rowbase + (NC - 1) * S::TC, h, vp, t2);
    __syncthreads();
}

template <bool NOSTORE> DI void attn_item(const Ctx& C, int item) {
    const int qb = item & 31; int r = item >> 5; const int h = r & 3; r >>= 2; const int g = r % 3, b = r / 3;
    const int dil = (g == 0) ? 1 : (g == 1) ? 4 : 16, nqb = 32 / dil;
    const int rho = qb / nqb, i0 = (qb % nqb) * 128;
    bf16_t* ZT = (bf16_t*)(C.ws + WS_ZT); float* LSE = (float*)(C.ws + WS_LSE);
    bf16_t* Ks = (bf16_t*)C.lds;
    bf16_t* Vt = Ks + 256 * 72;
    bf16_t* Ps = Vt + 64 * 280 + C.wave * 16 * 168;
    const size_t rowbase = (size_t)b * SEQ; const int qcol = g * 256 + h * 64;
    __syncthreads();
    for (int idx = C.tid; idx < 2048; idx += 512) {
        const int key = idx >> 3, ch = idx & 7, ki = i0 - 128 + key;
        u32x4 kv = (u32x4){0u, 0u, 0u, 0u}, vv = kv;
        if (ki >= 0) { const bf16_t* src = ZT + (rowbase + (size_t)ki * dil + rho) * 2304 + qcol + ch * 8; kv = *(const u32x4*)(src + 768); vv = *(const u32x4*)(src + 1536); }
        *(u32x4*)(Ks + key * 72 + ch * 8) = kv;
        bf16_t* vd = Vt + (ch * 8) * 280 + key;
        vd[0 * 280] = (bf16_t)(vv.x & 0xffff); vd[1 * 280] = (bf16_t)(vv.x >> 16); vd[2 * 280] = (bf16_t)(vv.y & 0xffff); vd[3 * 280] = (bf16_t)(vv.y >> 16);
        vd[4 * 280] = (bf16_t)(vv.z & 0xffff); vd[5 * 280] = (bf16_t)(vv.z >> 16); vd[6 * 280] = (bf16_t)(vv.w & 0xffff); vd[7 * 280] = (bf16_t)(vv.w >> 16);
    }
    for (int idx = C.tid; idx < 64 * 24; idx += 512) Vt[(idx / 24) * 280 + 256 + idx % 24] = 0;
    for (int idx = C.lane; idx < 16 * 16; idx += 64) Ps[(idx >> 4) * 168 + 144 + (idx & 15)] = 0;
    const int l15 = C.lane & 15, l4 = C.lane >> 4, w16 = C.wave * 16;
    bf16x8 qa0, qa1;
    { const size_t tq = rowbase + (size_t)(i0 + w16 + l15) * dil + rho; const bf16_t* qp = ZT + tq * 2304 + qcol; qa0 = *(const bf16x8*)(qp + l4 * 8); qa1 = *(const bf16x8*)(qp + 32 + l4 * 8); }
    __syncthreads();
    f32x4 s[9];
#pragma unroll
    for (int kb = 0; kb < 9; ++kb) {
        const bf16_t* kp = Ks + (w16 + kb * 16 + l15) * 72 + l4 * 8;
        const bf16x8 k0 = *(const bf16x8*)kp, k1 = *(const bf16x8*)(kp + 32);
        f32x4 z = (f32x4){0.f, 0.f, 0.f, 0.f};
        z = __builtin_amdgcn_mfma_f32_16x16x32_bf16(qa0, k0, z, 0, 0, 0);
        s[kb] = __builtin_amdgcn_mfma_f32_16x16x32_bf16(qa1, k1, z, 0, 0, 0);
    }
    float mx[4] = {-INFINITY, -INFINITY, -INFINITY, -INFINITY};
#pragma unroll
    for (int kb = 0; kb < 9; ++kb)
#pragma unroll
        for (int j = 0; j < 4; ++j) {
            const int rel = kb * 16 + l15 - (l4 * 4 + j);
            const int kabs = i0 - 128 + w16 + kb * 16 + l15;
            const bool ok = (rel >= 0) && (rel <= 128) && (kabs >= 0);
            const float v = ok ? s[kb][j] * 1.4426950408889634f : -INFINITY;
            s[kb][j] = v; mx[j] = fmaxf(mx[j], v);
        }
    float sm[4];
#pragma unroll
    for (int j = 0; j < 4; ++j) { mx[j] = grp_max16(mx[j]); sm[j] = 0.f; }
#pragma unroll
    for (int kb = 0; kb < 9; ++kb)
#pragma unroll
        for (int j = 0; j < 4; ++j) { const float p = __builtin_amdgcn_exp2f(s[kb][j] - mx[j]); sm[j] += p; Ps[(l4 * 4 + j) * 168 + kb * 16 + l15] = f2bf(p); }
#pragma unroll
    for (int j = 0; j < 4; ++j) sm[j] = grp_sum<16>(sm[j]);
    LDS_FENCE();
    f32x4 o[4];
#pragma unroll
    for (int db = 0; db < 4; ++db) o[db] = (f32x4){0.f, 0.f, 0.f, 0.f};
#pragma unroll
    for (int ks = 0; ks < 5; ++ks) {
        const bf16x8 pa = *(const bf16x8*)(Ps + l15 * 168 + ks * 32 + l4 * 8);
#pragma unroll
        for (int db = 0; db < 4; ++db) {
            const bf16x8 vb = *(const bf16x8*)(Vt + (db * 16 + l15) * 280 + w16 + ks * 32 + l4 * 8);
            o[db] = __builtin_amdgcn_mfma_f32_16x16x32_bf16(pa, vb, o[db], 0, 0, 0);
        }
    }
#pragma unroll
    for (int j = 0; j < 4; ++j) {
        const float inv = __builtin_amdgcn_rcpf(sm[j]);
        if (NOSTORE && !(sm[j] < 0.f)) continue;
        const size_t tq = rowbase + (size_t)(i0 + w16 + l4 * 4 + j) * dil + rho;
        bf16_t* op = ZT + tq * 2304 + qcol + l15;
#pragma unroll
        for (int db = 0; db < 4; ++db) op[db * 16] = f2bf(o[db][j] * inv);
        if (l15 == 0) LSE[tq * 12 + g * 4 + h] = (mx[j] + __builtin_amdgcn_logf(sm[j])) * 0.6931471805599453f;
    }
}
template <int PM  > DI void phase_D(const Ctx& C0) {
    Ctx C = C0;
    constexpr bool SCANS_ONLY = (PM == 1);
    volatile unsigned* lq = (volatile unsigned*)(C.lds + LDS_MISC);
    unsigned* ctr = (unsigned*)(C.ws + WS_CTL) + 64 * (1 + C.layer + (PM != 0 ? 2 : 0));
    constexpr int N_RW = 64, N_HG = 64, N_GLA = 32, N_AT = 4 * 3 * 4 * 32, N_MIX = N_RW + N_HG + N_GLA + (SCANS_ONLY ? 0 : N_AT);
    const int n_cw = CONV_REST + (C.layer == 0 ? CONV_WZ : 0), NTOT = N_MIX + (PM == 0 ? (n_cw + 7) / 8 : 0);
    for (;;) {
        __syncthreads();
        if (C.tid == 0) lq[0] = atomicAdd(ctr, 1u);
        __syncthreads();
        const int it = (int)lq[0];
        { unsigned char* w_ = C0.ws; KArg p_ = C0.p; asm volatile("" : "+s"(w_), "+s"(p_)); C.ws = w_; C.p = p_; }
        if (it >= NTOT) break;
        if (it < N_RW) scan_item<2>(C, it);
        else if (it < N_RW + N_HG) scan_item<0>(C, it - N_RW);
        else if (it < N_RW + N_HG + N_GLA) scan_item<1>(C, it - N_RW - N_HG);
        else if (it < N_MIX) attn_item<PM == 2>(C, it - N_RW - N_HG - N_GLA);
        else {
            const int wi = (it - N_MIX) * 8 + C.wave; float* scr = (float*)(C.lds + C.wave * 16384);
            const bool rest = wi < CONV_REST;
            if (wi < n_cw) conv_item(C, rest ? C.layer : 1, rest ? 1 : 0, rest ? wi : wi - CONV_REST, scr);
        }
    }
    __syncthreads();
}
DI void unpack4(u32x2 v, float* f) { f[0] = bflo(v.x); f[1] = bfhi(v.x); f[2] = bflo(v.y); f[3] = bfhi(v.y); }
DI u32x2 pack4(const float* f) { u32x2 v; v.x = pk2(f[0], f[1]); v.y = pk2(f[2], f[3]); return v; }
template <bool NOSTORE> DI void phase_E(const Ctx& C) {
    const int L = C.layer, lane = C.lane;
    bf16_t* OM = (bf16_t*)(C.ws + WS_OM);
    const bf16_t* ZA = (const bf16_t*)(C.ws + WS_ZA); const bf16_t* ZT = (const bf16_t*)(C.ws + WS_ZT);
    const bf16_t* VRW = (const bf16_t*)(C.ws + WS_VRW); const bf16_t* Sg = rw_slot(C, 0);
    const float* LSE = (const float*)(C.ws + WS_LSE); const float* BON = (const float*)(C.ws + WS_BONUS);
    const int c4 = lane * 4, h = lane >> 4;
    const f32x4 hgw = *(const f32x4*)(C.in(6) + L * 256 + c4), glw = *(const f32x4*)(C.in(9) + L * 256 + c4), lnw = *(const f32x4*)(C.in(19) + L * 256 + c4), lnb = *(const f32x4*)(C.in(20) + L * 256 + c4);
    const int gw = C.bid * 8 + C.wave, NGW = C.G * 8;
    for (int t = gw; t < T; t += NGW) {
        const size_t o = (size_t)t * 256 + c4;
        const u32x2 r0 = *(const u32x2*)(OM + o), r1 = *(const u32x2*)(OM + (size_t)T * 256 + o), r2 = *(const u32x2*)(OM + (size_t)2 * T * 256 + o);
        const u32x2 gh = *(const u32x2*)(ZA + (size_t)t * ZAW + 768 + c4), gg = *(const u32x2*)(ZA + (size_t)t * ZAW + 1536 + c4);
        const u32x2 vr = *(const u32x2*)(VRW + o), sg = *(const u32x2*)(Sg + o);
        const float bon = BON[t * 4 + h];
        const float l0 = LSE[t * 12 + h], l1 = LSE[t * 12 + 4 + h], l2 = LSE[t * 12 + 8 + h];
        const u32x2 a0 = *(const u32x2*)(ZT + (size_t)t * 2304 + c4), a1 = *(const u32x2*)(ZT + (size_t)t * 2304 + 256 + c4), a2 = *(const u32x2*)(ZT + (size_t)t * 2304 + 512 + c4);
        asm volatile("" ::: "memory");
        if (NOSTORE && !(l0 > 1e30f)) { if (bon > 1e30f && l1 > 1e30f && bflo(r0.x) + bflo(r1.x) + bflo(r2.x) + bflo(gh.x) + bflo(gg.x) + bflo(vr.x) + bflo(sg.x) + bflo(a0.x) + bflo(a1.x) + bflo(a2.x) + l2 > 1e30f) OM[o] = 0; continue; }
        float v[4], g[4], w[4], o4[4];
        {
            unpack4(r0, v); unpack4(gh, g);
            const float ms = grp_sum<16>((v[0] * v[0] + v[1] * v[1]) + (v[2] * v[2] + v[3] * v[3])) * (1.f / 64.f); const float rs = rsqrtf(ms + NEPS);
#pragma unroll
            for (int e = 0; e < 4; ++e) o4[e] = v[e] * rs * hgw[e] * sigmoidf_(g[e]);
            *(u32x2*)(OM + o) = pack4(o4);
        }
        {
            unpack4(r1, v); unpack4(gg, g);
            const float ms = grp_sum<16>((v[0] * v[0] + v[1] * v[1]) + (v[2] * v[2] + v[3] * v[3])) * (1.f / 64.f); const float rs = rsqrtf(ms + NEPS);
#pragma unroll
            for (int e = 0; e < 4; ++e) o4[e] = v[e] * rs * glw[e] * siluf_(g[e]);
            *(u32x2*)(OM + (size_t)T * 256 + o) = pack4(o4);
        }
        {
            unpack4(r2, v); unpack4(vr, w); unpack4(sg, g);
            const float mean = grp_sum<16>((v[0] + v[1]) + (v[2] + v[3])) * (1.f / 64.f);
            float d[4];
#pragma unroll
            for (int e = 0; e < 4; ++e) d[e] = v[e] - mean;
            const float var = grp_sum<16>((d[0] * d[0] + d[1] * d[1]) + (d[2] * d[2] + d[3] * d[3])) * (1.f / 64.f); const float rs = rsqrtf(var + 64e-5f);
#pragma unroll
            for (int e = 0; e < 4; ++e) o4[e] = (d[e] * rs * lnw[e] + lnb[e] + bon * w[e]) * g[e];
            *(u32x2*)(OM + (size_t)2 * T * 256 + o) = pack4(o4);
        }
        {
            const float m = fmaxf(l0, fmaxf(l1, l2));
            const float w0 = __expf(l0 - m), w1 = __expf(l1 - m), w2 = __expf(l2 - m), inv = __builtin_amdgcn_rcpf(w0 + w1 + w2);
            float x0[4], x1[4], x2[4]; unpack4(a0, x0); unpack4(a1, x1); unpack4(a2, x2);
#pragma unroll
            for (int e = 0; e < 4; ++e) o4[e] = (w0 * x0[e] + w1 * x1[e] + w2 * x2[e]) * inv;
            *(u32x2*)(OM + (size_t)3 * T * 256 + o) = pack4(o4);
        }
    }
    if (L > 0) rmsnorm_rows_bf16(C, C.p->out, C.in(1) + L * DM, (bf16_t*)(C.ws + WS_XN));
}
DI void phase_J(const Ctx& C) {
    const int L = C.layer;
    const bf16_t* U = (const bf16_t*)(C.ws + WS_U); bf16_t* Gb = (bf16_t*)(C.ws + WS_G);
    const float* cw = C.in(27) + (size_t)L * 3 * DFF; const float* cb = C.in(28) + (size_t)L * DFF;
    constexpr int NCG = DFF / 8, NRC = T / 32;
    for (int task = C.bid * 512 + C.tid; task < NCG * NRC; task += C.G * 512) {
        const int cgp = task % NCG, rc = task / NCG, f0 = cgp * 8, t0 = rc * 32;
        float w0[8], w1[8], w2[8], bb[8], u1[8], u2[8];
#pragma unroll
        for (int e = 0; e < 8; e += 4) { *(f32x4*)(w0 + e) = *(const f32x4*)(cw + f0 + e); *(f32x4*)(w1 + e) = *(const f32x4*)(cw + DFF + f0 + e); *(f32x4*)(w2 + e) = *(const f32x4*)(cw + 2 * DFF + f0 + e); *(f32x4*)(bb + e) = *(const f32x4*)(cb + f0 + e); }
        if ((t0 & (SEQ - 1)) != 0) { unpack8(*(const u32x4*)(U + (size_t)(t0 - 1) * DFF + f0), u1); unpack8(*(const u32x4*)(U + (size_t)(t0 - 2) * DFF + f0), u2); }
        else {
#pragma unroll
            for (int e = 0; e < 8; ++e) { u1[e] = 0.f; u2[e] = 0.f; }
        }
        for (int tb = t0; tb < t0 + 32; tb += 8) {
            u32x4 uw[8], gw8[8];
#pragma unroll
            for (int i = 0; i < 8; ++i) { uw[i] = *(const u32x4*)(U + (size_t)(tb + i) * DFF + f0); gw8[i] = *(const u32x4*)(Gb + (size_t)(tb + i) * DFF + f0); }
            asm volatile("" ::: "memory");
#pragma unroll
            for (int i = 0; i < 8; ++i) {
                float u0[8], g[8], a[8];
                unpack8(uw[i], u0); unpack8(gw8[i], g);
#pragma unroll
                for (int e = 0; e < 8; ++e) { const float v = bb[e] + w0[e] * u0[e] + w1[e] * u1[e] + w2[e] * u2[e]; a[e] = siluf_(v) * g[e]; u2[e] = u1[e]; u1[e] = u0[e]; }
                *(u32x4*)(Gb + (size_t)(tb + i) * DFF + f0) = pack8(a);
            }
        }
    }
}
DI void final_norm(const Ctx& C) {
    float* xo = C.p->out; const float* w = C.in(3);
    const int gw = C.bid * 8 + C.wave, NGW = C.G * 8;
    f32x4 wv[4];
#pragma unroll
    for (int j = 0; j < 4; ++j) wv[j] = *(const f32x4*)(w + 4 * C.lane + 256 * j);
    for (int m = gw; m < T; m += NGW) {
        float* xr = xo + (size_t)m * DM + 4 * C.lane; f32x4 v[4]; float s = 0.f;
#pragma unroll
        for (int j = 0; j < 4; ++j) { v[j] = *(const f32x4*)(xr + 256 * j); s += (v[j][0] * v[j][0] + v[j][1] * v[j][1]) + (v[j][2] * v[j][2] + v[j][3] * v[j][3]); }
        const float rstd = rsqrtf(wave_sum(s) * (1.f / DM) + NEPS);
#pragma unroll
        for (int j = 0; j < 4; ++j) *(f32x4*)(xr + 256 * j) = v[j] * rstd * wv[j];
    }
}

#define LAS __attribute__((address_space(3)))
constexpr int CW_BAR = 4096;
#define XB_TMO      128
#define XB_XCNT(j)  (256  + 64 * (j))
#define XB_XSUB(j)  (1280 + 64 * (j))
#define XB_XGEN(j)  (2304 + 64 * (j))
#define XB_TOP      3328
#define XB_TOPGEN   3392
#define XCD_BAR_WORDS 3456
#define XB_SPIN_CAP (1u << 18)

__device__ __forceinline__ unsigned xb_ld(unsigned* p)              { return __hip_atomic_load(p, __ATOMIC_RELAXED, __HIP_MEMORY_SCOPE_AGENT); }
__device__ __forceinline__ unsigned xb_add(unsigned* p, unsigned v) { return __hip_atomic_fetch_add(p, v, __ATOMIC_RELAXED, __HIP_MEMORY_SCOPE_AGENT); }
__device__ __forceinline__ unsigned xb_xcc_id() { return (unsigned)__builtin_amdgcn_s_getreg((3 << 11) | 20) & 0xFu; }
#define XB_SPIN(cond, bar) do { unsigned _sp = 0; while (cond) { __builtin_amdgcn_s_sleep(1); \
    if ((++_sp & 255u) == 0u) { if (xb_ld(&(bar)[XB_TMO])) break; if (_sp > XB_SPIN_CAP) { atomicAdd(&(bar)[XB_TMO], 1u); break; } } } } while (0)

struct XcdBarrier {
    unsigned* bar; unsigned x;
    volatile LAS unsigned* st;
};

__device__ __forceinline__ XcdBarrier xcd_barrier_post(unsigned* bar, volatile LAS unsigned* st) {
    XcdBarrier b; b.bar = bar; b.x = xb_xcc_id(); b.st = st;
    if (threadIdx.x == 0) (void)xb_add(&bar[XB_XCNT(b.x)], 1u);
    return b;
}
__device__ __forceinline__ void xcd_barrier_complete(unsigned* bar, unsigned x, unsigned& nloc, unsigned& nx) {
    const unsigned G = gridDim.x * gridDim.y * gridDim.z;
    unsigned sum, cnt, mine, sp = 0u;
    for (;;) {
        sum = 0u; cnt = 0u; mine = 0u;
#pragma unroll
        for (unsigned j = 0; j < 16; ++j) { const unsigned c = xb_ld(&bar[XB_XCNT(j)]); sum += c; cnt += (c > 0u) ? 1u : 0u; mine = (j == x) ? c : mine; }
        if (sum == G) break;
        __builtin_amdgcn_s_sleep(1);
        if ((++sp & 255u) == 0u) { if (xb_ld(&bar[XB_TMO])) break; if (sp > XB_SPIN_CAP) { atomicAdd(&bar[XB_TMO], 1u); break; } }
    }
    nloc = mine > 0u ? mine : 1u; nx = cnt > 0u ? cnt : 1u;
}

__device__ __forceinline__ void xcd_barrier(const XcdBarrier& b, const bool is_t0) {
    asm volatile("s_waitcnt vmcnt(0)" ::: "memory");
    __syncthreads();
    if (is_t0) {
        unsigned* bar = b.bar;
        __builtin_amdgcn_s_waitcnt(0);
        unsigned nloc = b.st[0], nx = b.st[1];
        if (nloc == 0u) { xcd_barrier_complete(bar, b.x, nloc, nx); b.st[0] = nloc; b.st[1] = nx; }
        const unsigned old = xb_add(&bar[XB_XSUB(b.x)], 1u);
        const unsigned gen = old / nloc;
        if (old + 1u == (gen + 1u) * nloc) {
            __builtin_amdgcn_fence(__ATOMIC_RELEASE, "agent");
            asm volatile("s_waitcnt vmcnt(0)" ::: "memory");
            const unsigned og = xb_add(&bar[XB_TOP], 1u);
            const unsigned tg = og / nx;
            if (og + 1u == (tg + 1u) * nx) xb_add(&bar[XB_TOPGEN], 1u);
            else XB_SPIN(xb_ld(&bar[XB_TOPGEN]) == tg, bar);
            __builtin_amdgcn_fence(__ATOMIC_ACQUIRE, "agent");
            xb_add(&bar[XB_XGEN(b.x)], 1u);
            asm volatile("s_waitcnt vmcnt(0)" ::: "memory");
        } else {
            XB_SPIN(xb_ld(&bar[XB_XGEN(b.x)]) == gen, bar);
            __builtin_amdgcn_fence(__ATOMIC_ACQUIRE, "agent");
            asm volatile("s_waitcnt vmcnt(0)" ::: "memory");
        }
    }
    __syncthreads();
}

#ifndef DUP
#define DUP 0
#endif
#ifndef PHM
#define PHM 2047
#endif
DI Ctx mkctx_(int L, unsigned char* lds, int wave0) {
    KArg ka = (KArg)__builtin_amdgcn_kernarg_segment_ptr(); int tv = wave0 * 64 + lane_id_(), lv = L, gv = gridDim.x, bv = blockIdx.x;
    asm volatile("" : "+s"(ka), "+v"(tv), "+s"(lv), "+s"(gv), "+s"(bv));
    Ctx C; C.p = ka; C.tid = tv; C.lane = tv & 63; C.wave = wave0; C.G = gv; C.bid = bv; C.ws = ka->ws; C.lds = lds; C.layer = lv;
    return C;
}
DI void grid_bar_(unsigned char* lds, int wave0) {
    KArg ka = (KArg)__builtin_amdgcn_kernarg_segment_ptr(); asm volatile("" : "+s"(ka));
    XcdBarrier b; b.bar = (unsigned*)(ka->ws + WS_CTL) + CW_BAR; b.x = xb_xcc_id(); b.st = (volatile LAS unsigned*)(LAS unsigned char*)(lds + LDS_MISC + 32);
    xcd_barrier(b, wave0 == 0 && lane_id_() == 0);
#if DUP & 1024
    xcd_barrier(b, wave0 == 0 && lane_id_() == 0);
#endif
}
template <int L> DI void run_layer(cg::grid_group& grid, unsigned char* lds, int wave0) {
    PG8_LAS unsigned char* ldsl = (PG8_LAS unsigned char*)lds;
#if PHM & 1
        { const Ctx C = mkctx_(L, lds, wave0); phase_A(C); }
#if DUP & 2
        { const Ctx C = mkctx_(L, lds, wave0); phase_A(C); }
#endif
#endif
        grid_bar_(lds, wave0);
        if (L == 0 && gridDim.x == 0x7fffffffu) grid.sync();
#if PHM & 2
        {
            const Ctx C = mkctx_(L, lds, wave0); const bf16_t* XN = (L == 0) ? (const bf16_t*)C.p->out : (const bf16_t*)(C.ws + WS_XN);
            pg8::Gemm g{XN, (const bf16_t*)(C.ws + WS_WZ), T, NZ, 1024}; pg8::StaticOrder S; S.init(T, NZ, C.G, C.bid);
            EpiZ E{(bf16_t*)(C.ws + WS_ZA), (bf16_t*)(C.ws + WS_OM), (bf16_t*)(C.ws + WS_ZT), (const float*)(C.ws + WS_ROPEC), (const float*)(C.ws + WS_ROPES)};
            pg8::gemm_phase<EpiZ, pg8::StaticOrder, true, true>(ldsl, g, S, E, C.wave);
#if DUP & 1
            pg8::gemm_phase<EpiZ, pg8::StaticOrder, true, true>(ldsl, g, S, E, C.wave);
#endif
        }
#endif
        grid_bar_(lds, wave0);
#if PHM & 4
        { const Ctx C = mkctx_(L, lds, wave0); phase_C(C); }
#if DUP & 2
        if (L == 0) { const Ctx C = mkctx_(L, lds, wave0); phase_C(C); }
#endif
#endif
        grid_bar_(lds, wave0);
#if PHM & 8
#if DUP & 4
        { const Ctx C = mkctx_(L, lds, wave0); phase_D<1>(C); }
#endif
#if DUP & 8
        { const Ctx C = mkctx_(L, lds, wave0); phase_D<2>(C); }
#endif
        { const Ctx C = mkctx_(L, lds, wave0); phase_D<0>(C); }
#endif
        grid_bar_(lds, wave0);
#if PHM & 16
#if DUP & 2048
        { const Ctx C = mkctx_(L, lds, wave0); phase_E<true>(C); }
#endif
        { const Ctx C = mkctx_(L, lds, wave0); phase_E<false>(C); }
#endif
        grid_bar_(lds, wave0);
#if PHM & 64
        {
            const Ctx C = mkctx_(L, lds, wave0);
            pg8::Gemm g{(const bf16_t*)(C.ws + WS_OM), (const bf16_t*)(C.ws + WS_WB), 4 * T, 4096, 256}; ProjOrder S{C.G, C.bid};
            EpiSplit<0> E{(bf16_t*)(C.ws + WS_PROJ), 1024, 4, 0};
            pg8::gemm_phase<EpiSplit<0>, ProjOrder, true, true>(ldsl, g, S, E, C.wave);
        }
#endif
        __syncthreads();
#if PHM & 32
        {
            const Ctx C = mkctx_(L, lds, wave0); const bf16_t* XN = (L == 0) ? (const bf16_t*)C.p->out : (const bf16_t*)(C.ws + WS_XN);
            pg8::Gemm g{XN, (const bf16_t*)(C.ws + WS_WG), T, 4096, 1024}; GateOrder S{C.G, C.bid};
            EpiGateMerge E{(const bf16_t*)(C.ws + WS_PROJ), (bf16_t*)(C.ws + WS_MERGED)};
            pg8::gemm_phase<EpiGateMerge, GateOrder, true, true>(ldsl, g, S, E, C.wave);
        }
#endif
        grid_bar_(lds, wave0);
#if PHM & 128
        {
            const Ctx C = mkctx_(L, lds, wave0);
            pg8::Gemm g{(const bf16_t*)(C.ws + WS_MERGED), (const bf16_t*)(C.ws + WS_WO), T, 1024, 1024}; pg8::StaticOrder S; S.init(T, 1024, C.G, C.bid);
            EpiRes<true> E{(C.layer == 0) ? C.p->in[0] : (const float*)C.p->out, C.p->out, (bf16_t*)(C.ws + WS_XN2), (float*)(C.ws + WS_SSQ)};
            pg8::gemm_phase<EpiRes<true>, pg8::StaticOrder, true, true>(ldsl, g, S, E, C.wave);
        }
#endif
        grid_bar_(lds, wave0);
#if PHM & 256
        {
            const Ctx C = mkctx_(L, lds, wave0);
            pg8::Gemm g{(const bf16_t*)(C.ws + WS_XN2), (const bf16_t*)(C.ws + WS_WUP), T, 2 * DFF, 1024}; pg8::StaticOrder S; S.init(T, 2 * DFF, C.G, C.bid);
            EpiUpAct E{(bf16_t*)(C.ws + WS_ACT), (const float*)(C.ws + WS_SSQ), C.in(27) + (size_t)C.layer * 3 * DFF, C.in(28) + (size_t)C.layer * DFF, (float*)(C.ws + WS_EDGE), (PG8_LAS float*)(ldsl + LDS_MISC + 1024)};
            pg8::gemm_phase<EpiUpAct, pg8::StaticOrder, true, true>(ldsl, g, S, E, C.wave);
        }
#endif
        grid_bar_(lds, wave0);
#if PHM & 1024
        {
            const Ctx C = mkctx_(L, lds, wave0);
            pg8::Gemm g{(const bf16_t*)(C.ws + WS_ACT), (const bf16_t*)(C.ws + WS_WDN), T, 1024, DFF}; pg8::StaticOrder S; S.init(T, 1024, C.G, C.bid);
            { pg8::Unit uu; for (int i = 0; S.next(i, uu); ++i) ffn_edge_fixup(C, uu.pm); }
            asm volatile("s_waitcnt vmcnt(0)" ::: "memory"); __syncthreads();
            EpiRes<false> E{C.p->out, C.p->out, nullptr, nullptr};
            pg8::gemm_phase<EpiRes<false>, pg8::StaticOrder, true, true>(ldsl, g, S, E, C.wave);
        }
#endif
        grid_bar_(lds, wave0);
    }
__global__ void __launch_bounds__(512, 2) fwd_megakernel(Params prm) {
    extern __shared__ __attribute__((aligned(16))) unsigned char lds[];
    cg::grid_group grid = cg::this_grid();
    const int wave0 = __builtin_amdgcn_readfirstlane(threadIdx.x >> 6);
    if (threadIdx.x < 16) ((volatile LAS unsigned*)(LAS unsigned char*)(lds + LDS_MISC))[threadIdx.x] = 0u;
    __syncthreads();
    (void)xcd_barrier_post((unsigned*)(prm.ws + WS_CTL) + CW_BAR, (volatile LAS unsigned*)(LAS unsigned char*)(lds + LDS_MISC + 32));
    run_layer<0>(grid, lds, wave0);
    run_layer<1>(grid, lds, wave0);
    { const Ctx C = mkctx_(0, lds, wave0); final_norm(C); }
}

extern "C" void kernel_launch(void* const* d_in, const int* in_sizes, int n_in, void* d_out, int out_size, void* d_ws, size_t ws_size, hipStream_t stream) {
    static int grid = 0;
    if (grid == 0) {
        if (n_in != 30 || out_size != T * DM || ws_size < WS_END) { fprintf(stderr, "kernel_launch: unexpected problem (n_in %d out %d ws %zu)\n", n_in, out_size, ws_size); grid = -1; return; }
        int dev = 0, cus = 0, per_cu = 0;
        (void)hipGetDevice(&dev); (void)hipDeviceGetAttribute(&cus, hipDeviceAttributeMultiprocessorCount, dev);
        (void)hipFuncSetAttribute((const void*)fwd_megakernel, hipFuncAttributeMaxDynamicSharedMemorySize, LDS_BYTES);
        (void)hipOccupancyMaxActiveBlocksPerMultiprocessor(&per_cu, (const void*)fwd_megakernel, 512, LDS_BYTES);
        if (per_cu < 1) { fprintf(stderr, "kernel_launch: occupancy query says %d\n", per_cu); per_cu = 1; }
        (void)hipGetLastError();
        grid = cus * 1;
    }
    if (grid < 0) return;
    (void)hipMemsetAsync((char*)d_ws + WS_CTL, 0, 65536, stream);
    Params p{};
    for (int i = 0; i < 30; ++i) p.in[i] = (const float*)d_in[i];
    p.out = (float*)d_out; p.ws = (unsigned char*)d_ws;
    void* args[] = {&p};
    hipError_t e = hipLaunchCooperativeKernel((const void*)fwd_megakernel, dim3(grid), dim3(512), args, LDS_BYTES, stream);
    if (e != hipSuccess) fprintf(stderr, "cooperative launch failed: %s (grid %d)\n", hipGetErrorString(e), grid);
}
```
